# Optimizing an MI355X kernel written in HIP

```python
import math
import jax, jax.numpy as jnp
from jax import lax
import numpy as np

D_MODEL = 1024
BATCH = 2
SEQ = 8192
DEPTH = 2

HEAD_DIM = 64
N_HEADS_MOBA = 6
N_HEADS_SSD = 6
N_HEADS_DIL = 6
N_HEADS_DELTA = 6
W_MOBA = N_HEADS_MOBA * HEAD_DIM
W_SSD = N_HEADS_SSD * HEAD_DIM
W_DIL = N_HEADS_DIL * HEAD_DIM
W_DELTA = N_HEADS_DELTA * HEAD_DIM
D_MIX = W_MOBA + W_SSD + W_DIL + W_DELTA

MOBA_BLOCK = 256
MOBA_TOPK = 3
MOBA_Q_CHUNK = 64

SSD_STATE = 128
SSD_GROUPS = 2
SSD_CHUNK = 128
SSD_XBC = W_SSD + 2 * SSD_GROUPS * SSD_STATE

CONV_WIDTH = 4

DIL_PAIRS = ((128, 1), (512, 4), (2048, 16))
DIL_Q_CHUNK = 128

DELTA_CHUNK = 64
DELTA_QKV = 3 * W_DELTA

LN_EPS = 1e-5
RMS_EPS = 1e-6
DEEPNORM_ALPHA = (2.0 * DEPTH) ** 0.25
DEEPNORM_BETA = (8.0 * DEPTH) ** -0.25

IN_SPLIT_SIZES = (
    W_MOBA, W_MOBA, W_MOBA, W_MOBA,
    SSD_XBC, W_SSD, N_HEADS_SSD,
    W_DIL, W_DIL, W_DIL, W_DIL,
    DELTA_QKV, W_DELTA, N_HEADS_DELTA, N_HEADS_DELTA,
)
IN_COLS = int(sum(IN_SPLIT_SIZES))
IN_SPLIT_POINTS = tuple(int(i) for i in np.cumsum(IN_SPLIT_SIZES)[:-1])

kernel_name = "hymba_style_moba_ssd_dilated_gdn_deepnorm"

NEG_INF = -jnp.inf


def alibi_slopes():
    n = N_HEADS_DIL + N_HEADS_MOBA
    s = 2.0 ** (-8.0 * (np.arange(n) + 1) / n)
    s = jnp.asarray(s, dtype=jnp.float32)
    return s[:N_HEADS_DIL], s[N_HEADS_DIL:]


def layer_norm(x, g, b):
    xf = x.astype(jnp.float32)
    mu = xf.mean(-1, keepdims=True)
    var = jnp.square(xf - mu).mean(-1, keepdims=True)
    return ((xf - mu) * lax.rsqrt(var + LN_EPS) * g + b).astype(x.dtype)


def rms_norm(x, w):
    xf = x.astype(jnp.float32)
    return (xf * lax.rsqrt(jnp.mean(xf * xf, -1, keepdims=True) + RMS_EPS) * w).astype(x.dtype)


def l2_normalize(x):
    xf = x.astype(jnp.float32)
    return xf * lax.rsqrt(jnp.sum(xf * xf, -1, keepdims=True) + RMS_EPS)


def causal_dw_conv(x, w, b):
    K, C = w.shape
    y = lax.conv_general_dilated(
        x, w[:, None, :].astype(x.dtype), window_strides=(1,), padding=[(K - 1, 0)],
        dimension_numbers=("NWC", "WIO", "NWC"), feature_group_count=C)
    return y + b.astype(x.dtype)


def moba_attention(q, k, v, slopes):
    Bsz, S, H, Dh = q.shape
    L = MOBA_BLOCK
    nblk = -(-S // L)
    pad = nblk * L - S
    scale = Dh ** -0.5
    kp = jnp.pad(k, ((0, 0), (0, pad), (0, 0), (0, 0)))
    vp = jnp.pad(v, ((0, 0), (0, pad), (0, 0), (0, 0)))
    kb = kp.reshape(Bsz, nblk, L, H, Dh).transpose(0, 3, 1, 2, 4)
    vb = vp.reshape(Bsz, nblk, L, H, Dh).transpose(0, 3, 1, 2, 4)
    kmean = kb.astype(jnp.float32).mean(axis=3)
    qt = q.transpose(0, 2, 1, 3)

    gate = jnp.einsum("bhsd,bhnd->bhsn", qt.astype(jnp.float32), kmean)
    qblk = jnp.arange(S) // L
    past = jnp.arange(nblk)[None, :] < qblk[:, None]
    gate = jnp.where(past[None, None], gate, NEG_INF)
    k_sel = min(MOBA_TOPK, nblk)
    _, sel = lax.top_k(gate, k_sel)
    valid = sel < qblk[None, None, :, None]

    bi = jnp.arange(Bsz)[:, None, None, None]
    hi = jnp.arange(H)[None, :, None, None]
    Qc = MOBA_Q_CHUNK
    sl = slopes[None, :, None, None]

    def chunk(c):
        t0 = c * Qc
        tq = t0 + jnp.arange(Qc)
        qc = lax.dynamic_slice_in_dim(qt, t0, Qc, axis=2)
        selc = lax.dynamic_slice_in_dim(sel, t0, Qc, axis=2)
        validc = lax.dynamic_slice_in_dim(valid, t0, Qc, axis=2)
        kg = kb[bi, hi, selc]
        vg = vb[bi, hi, selc]
        pos_g = selc[..., None] * L + jnp.arange(L)
        dist_g = (tq[None, None, :, None, None] - pos_g).astype(jnp.float32)
        s_g = jnp.einsum("bhqd,bhqjld->bhqjl", qc, kg).astype(jnp.float32) * scale
        s_g = s_g - sl[..., None] * dist_g
        s_g = jnp.where(validc[..., None], s_g, NEG_INF).reshape(Bsz, H, Qc, k_sel * L)
        own = t0 // L
        ko = lax.dynamic_index_in_dim(kb, own, axis=2, keepdims=False)
        vo = lax.dynamic_index_in_dim(vb, own, axis=2, keepdims=False)
        pos_o = own * L + jnp.arange(L)
        dist_o = (tq[:, None] - pos_o[None, :]).astype(jnp.float32)
        s_o = jnp.einsum("bhqd,bhld->bhql", qc, ko).astype(jnp.float32) * scale
        s_o = s_o - sl * dist_o[None, None]
        s_o = jnp.where((pos_o[None, :] <= tq[:, None])[None, None], s_o, NEG_INF)
        p = jax.nn.softmax(jnp.concatenate([s_g, s_o], axis=-1), axis=-1).astype(v.dtype)
        p_g = p[..., :k_sel * L].reshape(Bsz, H, Qc, k_sel, L)
        p_o = p[..., k_sel * L:]
        return (jnp.einsum("bhqjl,bhqjld->bhqd", p_g, vg)
                + jnp.einsum("bhql,bhld->bhqd", p_o, vo))

    outs = lax.map(chunk, jnp.arange(S // Qc))
    return outs.transpose(1, 0, 3, 2, 4).reshape(Bsz, S, H, Dh)


def ssd_chunked(X, a, Bh, Ch):
    Bsz, S, H, P = X.shape
    N = Bh.shape[-1]
    L = SSD_CHUNK
    nc = S // L
    X = X.reshape(Bsz, nc, L, H, P)
    Bc = Bh.reshape(Bsz, nc, L, H, N)
    Cc = Ch.reshape(Bsz, nc, L, H, N)
    a = a.reshape(Bsz, nc, L, H).transpose(0, 3, 1, 2)
    a_cum = jnp.cumsum(a, axis=-1)
    causal = jnp.tril(jnp.ones((L, L), dtype=bool))
    Lmat = jnp.exp(jnp.where(causal, a_cum[..., :, None] - a_cum[..., None, :], NEG_INF))
    scores = jnp.einsum("bclhn,bcshn->bhcls", Cc, Bc)
    y_diag = jnp.einsum("bhcls,bcshp->bclhp", scores * Lmat, X)
    decay_states = jnp.exp(a_cum[..., -1:] - a_cum)
    states = jnp.einsum("bclhn,bhcl,bclhp->bchpn", Bc, decay_states, X)
    chunk_decay = jnp.exp(a_cum[..., -1])

    def step(h, inp):
        st, dec = inp
        return h * dec[..., None, None] + st, h

    h0 = jnp.zeros((Bsz, H, P, N), dtype=X.dtype)
    _, h_prev = lax.scan(step, h0, (jnp.moveaxis(states, 1, 0), jnp.moveaxis(chunk_decay, 2, 0)))
    h_prev = jnp.moveaxis(h_prev, 0, 1)
    y_off = jnp.einsum("bclhn,bchpn,bhcl->bclhp", Cc, h_prev, jnp.exp(a_cum))
    return (y_diag + y_off).reshape(Bsz, S, H, P)


def ssd_mixer(xbc, dt_raw, dt_bias, A_log, D_skip):
    Bsz, S, _ = xbc.shape
    xbc = xbc.astype(jnp.float32)
    xs, Bm, Cm = jnp.split(xbc, [W_SSD, W_SSD + SSD_GROUPS * SSD_STATE], axis=-1)
    xs = xs.reshape(Bsz, S, N_HEADS_SSD, HEAD_DIM)
    hpg = N_HEADS_SSD // SSD_GROUPS
    Bh = jnp.repeat(Bm.reshape(Bsz, S, SSD_GROUPS, SSD_STATE), hpg, axis=2)
    Ch = jnp.repeat(Cm.reshape(Bsz, S, SSD_GROUPS, SSD_STATE), hpg, axis=2)
    dt = jax.nn.softplus(dt_raw.astype(jnp.float32) + dt_bias)
    A = -jnp.exp(A_log.astype(jnp.float32))
    y = ssd_chunked(xs * dt[..., None], dt * A, Bh, Ch)
    y = y + D_skip.astype(jnp.float32)[:, None] * xs
    return y.reshape(Bsz, S, W_SSD)


def dilated_attention(q, k, v, slopes):
    Bsz, S, H, Dh = q.shape
    scale = Dh ** -0.5
    Qc = DIL_Q_CHUNK
    sl = slopes[None, :, None, None]

    def chunk(c):
        t0 = c * Qc
        tq = t0 + jnp.arange(Qc)
        qc = lax.dynamic_slice_in_dim(q, t0, Qc, axis=1)
        outs, lses = [], []
        for (w, d) in DIL_PAIRS:
            nk = w // d + 1
            dist = d * jnp.arange(nk)
            idx = tq[:, None] - dist[None, :]
            ok = idx >= 0
            idxc = jnp.maximum(idx, 0)
            kg = jnp.take(k, idxc, axis=1)
            vg = jnp.take(v, idxc, axis=1)
            s = jnp.einsum("bqhd,bqnhd->bhqn", qc, kg).astype(jnp.float32) * scale
            s = s - sl * dist.astype(jnp.float32)[None, None, None, :]
            s = jnp.where(ok[None, None], s, NEG_INF)
            m = jnp.max(s, axis=-1, keepdims=True)
            e = jnp.exp(s - m)
            den = jnp.sum(e, axis=-1, keepdims=True)
            outs.append(jnp.einsum("bhqn,bqnhd->bhqd", (e / den).astype(v.dtype), vg).astype(jnp.float32))
            lses.append(m + jnp.log(den))
        wts = jax.nn.softmax(jnp.concatenate(lses, axis=-1), axis=-1)
        out = sum(wts[..., g:g + 1] * outs[g] for g in range(len(DIL_PAIRS)))
        return out.astype(v.dtype)

    outs = lax.map(chunk, jnp.arange(S // Qc))
    return outs.transpose(1, 0, 3, 2, 4).reshape(Bsz, S, H, Dh)


def gated_delta_chunked(q, k, v, beta, g):
    Bsz, S, H, Dk = q.shape
    Dv = v.shape[-1]
    C = DELTA_CHUNK
    nc = S // C

    def to_chunks(t):
        return t.reshape(Bsz, nc, C, H, -1).transpose(0, 3, 1, 2, 4)

    q, k, v = to_chunks(q), to_chunks(k), to_chunks(v)
    beta = beta.reshape(Bsz, nc, C, H).transpose(0, 3, 1, 2)
    g_cum = jnp.cumsum(g.reshape(Bsz, nc, C, H).transpose(0, 3, 1, 2), axis=-1)
    incl = jnp.tril(jnp.ones((C, C), dtype=bool))
    strict = jnp.tril(jnp.ones((C, C), dtype=bool), -1)
    decay = jnp.exp(jnp.where(incl, g_cum[..., :, None] - g_cum[..., None, :], NEG_INF))
    kb = k * beta[..., None]
    Lm = jnp.where(strict, jnp.einsum("bhcid,bhcjd->bhcij", kb, k) * decay, 0.0)
    eye = jnp.eye(C, dtype=q.dtype)
    T = lax.linalg.triangular_solve(eye + Lm, jnp.broadcast_to(eye, Lm.shape),
                                    left_side=True, lower=True, unit_diagonal=True)
    u = T @ (v * beta[..., None])
    w = T @ (kb * jnp.exp(g_cum)[..., None])
    attn = jnp.where(incl, jnp.einsum("bhcid,bhcjd->bhcij", q, k) * decay, 0.0)

    def step(St, inp):
        qc, kc, uc, wc, gc, ac = inp
        v_new = uc - wc @ St
        o = (qc * jnp.exp(gc)[..., None]) @ St + ac @ v_new
        glast = gc[..., -1]
        St = St * jnp.exp(glast)[..., None, None] + jnp.einsum(
            "bhcd,bhce->bhde", kc * jnp.exp(glast[..., None] - gc)[..., None], v_new)
        return St, o

    xs = tuple(jnp.moveaxis(t, 2, 0) for t in (q, k, u, w, g_cum, attn))
    S0 = jnp.zeros((Bsz, H, Dk, Dv), dtype=q.dtype)
    _, o = lax.scan(step, S0, xs)
    return o.transpose(1, 0, 3, 2, 4).reshape(Bsz, S, H, Dv)


def hybrid_layer(x, w_in, w_out, ssm_conv_w, ssm_conv_b, ssm_dt_bias, ssm_A_log, ssm_D,
                 ssm_norm_w, dn_conv_w, dn_conv_b, dn_dt_bias, dn_A_log, dn_norm_w, ln_g, ln_b):
    Bsz, S, _ = x.shape
    slopes_dil, slopes_moba = alibi_slopes()
    proj = x @ w_in
    (a_q, a_k, a_v, a_g, s_xbc, s_z, s_dt, c_q, c_k, c_v, c_g,
     d_qkv, d_g, d_b, d_a) = jnp.split(proj, IN_SPLIT_POINTS, axis=-1)

    def heads(t):
        return t.reshape(Bsz, S, -1, HEAD_DIM)

    y_a = moba_attention(heads(a_q), heads(a_k), heads(a_v), slopes_moba).reshape(Bsz, S, W_MOBA)
    y_a = y_a * jax.nn.silu(a_g)

    xbc = jax.nn.silu(causal_dw_conv(s_xbc, ssm_conv_w, ssm_conv_b))
    y_b = ssd_mixer(xbc, s_dt, ssm_dt_bias, ssm_A_log, ssm_D)
    y_b = rms_norm(y_b * jax.nn.silu(s_z.astype(jnp.float32)), ssm_norm_w).astype(x.dtype)

    y_c = dilated_attention(heads(c_q), heads(c_k), heads(c_v), slopes_dil).reshape(Bsz, S, W_DIL)
    y_c = y_c * jax.nn.silu(c_g)

    qkv = jax.nn.silu(causal_dw_conv(d_qkv, dn_conv_w, dn_conv_b))
    dq, dk, dv = jnp.split(qkv, [W_DELTA, 2 * W_DELTA], axis=-1)
    dq = l2_normalize(heads(dq)) * (HEAD_DIM ** -0.5)
    dk = l2_normalize(heads(dk))
    dv = heads(dv).astype(jnp.float32)
    d_beta = jax.nn.sigmoid(d_b.astype(jnp.float32))
    d_logdecay = -jnp.exp(dn_A_log.astype(jnp.float32)) * jax.nn.softplus(
        d_a.astype(jnp.float32) + dn_dt_bias)
    o_d = gated_delta_chunked(dq, dk, dv, d_beta, d_logdecay)
    y_d = rms_norm(o_d, dn_norm_w).reshape(Bsz, S, W_DELTA).astype(x.dtype) * jax.nn.silu(d_g)

    mix = jnp.concatenate([y_a, y_b, y_c, y_d], axis=-1) @ w_out
    return layer_norm(DEEPNORM_ALPHA * x + mix, ln_g, ln_b)


def setup_inputs(seed: int = 0) -> dict:
    key = jax.random.key(seed)
    ks = jax.random.split(key, 20)
    f32 = jnp.float32

    def inv_softplus_dt(k, shape):
        dt = jnp.exp(jax.random.uniform(k, shape, f32, math.log(1e-3), math.log(1e-1)))
        return dt + jnp.log(-jnp.expm1(-dt))

    return {
        "x": jax.random.normal(ks[0], (BATCH, SEQ, D_MODEL), f32),
        "w_in": jax.random.normal(ks[1], (DEPTH, D_MODEL, IN_COLS), f32) * D_MODEL ** -0.5,
        "w_out": jax.random.normal(ks[2], (DEPTH, D_MIX, D_MODEL), f32) * (D_MIX ** -0.5) * DEEPNORM_BETA,
        "ssm_conv_w": jax.random.normal(ks[3], (DEPTH, CONV_WIDTH, SSD_XBC), f32) * CONV_WIDTH ** -0.5,
        "ssm_conv_b": jax.random.normal(ks[4], (DEPTH, SSD_XBC), f32) * 0.01,
        "ssm_dt_bias": inv_softplus_dt(ks[5], (DEPTH, N_HEADS_SSD)),
        "ssm_A_log": jnp.log(jax.random.uniform(ks[6], (DEPTH, N_HEADS_SSD), f32, 1.0, 16.0)),
        "ssm_D": 1.0 + 0.01 * jax.random.normal(ks[7], (DEPTH, N_HEADS_SSD), f32),
        "ssm_norm_w": 1.0 + 0.01 * jax.random.normal(ks[8], (DEPTH, W_SSD), f32),
        "dn_conv_w": jax.random.normal(ks[9], (DEPTH, CONV_WIDTH, DELTA_QKV), f32) * CONV_WIDTH ** -0.5,
        "dn_conv_b": jax.random.normal(ks[10], (DEPTH, DELTA_QKV), f32) * 0.01,
        "dn_dt_bias": inv_softplus_dt(ks[11], (DEPTH, N_HEADS_DELTA)),
        "dn_A_log": jnp.log(jax.random.uniform(ks[12], (DEPTH, N_HEADS_DELTA), f32, 1.0, 16.0)),
        "dn_norm_w": 1.0 + 0.01 * jax.random.normal(ks[13], (DEPTH, HEAD_DIM), f32),
        "ln_g": 1.0 + 0.01 * jax.random.normal(ks[14], (DEPTH, D_MODEL), f32),
        "ln_b": 0.01 * jax.random.normal(ks[15], (DEPTH, D_MODEL), f32),
    }


def reference(x, w_in, w_out, ssm_conv_w, ssm_conv_b, ssm_dt_bias, ssm_A_log, ssm_D,
              ssm_norm_w, dn_conv_w, dn_conv_b, dn_dt_bias, dn_A_log, dn_norm_w, ln_g, ln_b):
    for l in range(DEPTH):
        x = hybrid_layer(x, w_in[l], w_out[l], ssm_conv_w[l], ssm_conv_b[l], ssm_dt_bias[l],
                         ssm_A_log[l], ssm_D[l], ssm_norm_w[l], dn_conv_w[l], dn_conv_b[l],
                         dn_dt_bias[l], dn_A_log[l], dn_norm_w[l], ln_g[l], ln_b[l])
    return x
```

```cpp
#include <hip/hip_runtime.h>
#include <hip/hip_cooperative_groups.h>
#include <cstdio>
#include <cstdint>
namespace cg = cooperative_groups;

typedef unsigned short bf16_t;
typedef short bf16x8 __attribute__((ext_vector_type(8)));
typedef short bf16x4 __attribute__((ext_vector_type(4)));
typedef float f32x4 __attribute__((ext_vector_type(4)));

constexpr int NTOK = 16384, SEQ = 8192, DM = 1024, LDP = 5888, INC = 5906, DMIX = 1536;
constexpr int NWIN = 6144;
constexpr int C_AQ = 0, C_AK = 384, C_AV = 768, C_AG = 1152, C_SX = 1536, C_SB = 1920, C_SC = 2176, C_SZ = 2432;
constexpr int C_CQ = 2816, C_CK = 3200, C_CV = 3584, C_CG = 3968, C_DQ = 4352, C_DK = 4736, C_DV = 5120, C_DG = 5504;
constexpr float DN_ALPHA = 1.4142135623730951f;

constexpr size_t WS_P = 0;
constexpr size_t WS_SM = WS_P + (size_t)NTOK * LDP * 2;
constexpr size_t WS_WINT = WS_SM + (size_t)NTOK * 32 * 4;
constexpr size_t WS_WOUTT = WS_WINT + (size_t)NWIN * 1024 * 2;
constexpr size_t WS_HALO = WS_WOUTT + (size_t)2 * 1024 * 1536 * 2;
constexpr size_t WS_WB = WS_HALO + (size_t)256 * 3 * 1152 * 2;
constexpr size_t WS_GC = WS_WB + (size_t)NTOK * 384 * 2;
constexpr size_t WS_DILO = WS_GC + (size_t)NTOK * 8 * 4;
constexpr size_t WS_DILL = WS_DILO + (size_t)NTOK * 384 * 2;
constexpr size_t WS_ST = WS_DILL + (size_t)NTOK * 8 * 4;
constexpr size_t WS_CDEC = WS_ST + (size_t)2 * 64 * 6 * 8192 * 2;
constexpr size_t WS_KMEAN = WS_CDEC + 4096;
constexpr size_t WS_QB = WS_KMEAN + (size_t)2 * 6 * 32 * 64 * 4;
constexpr size_t WS_XBAR = WS_QB + (size_t)256 * 6 * 4096 * 2;
constexpr size_t WS_CUTAB = WS_XBAR + 16384;
constexpr size_t WS_CTR = WS_CUTAB + 2 * 16384 + 64;
constexpr size_t WS_END = WS_CTR + 1024;
constexpr size_t WS_SB = WS_WINT;
static_assert((size_t)256 * 6 * 4096 * 2 <= (size_t)NWIN * 1024 * 2, "SB alias overflow");
constexpr size_t WS_XB = WS_WB;
static_assert(WS_XB + (size_t)NTOK * 1024 * 2 <= WS_CDEC, "XB alias overflow");

constexpr int LDS_BYTES = 79 * 1024;
#ifndef PROBE
#define PROBE 0
#endif

struct Params {
    const float* x; const float* w_in; const float* w_out;
    const float* ssm_conv_w; const float* ssm_conv_b; const float* ssm_dt_bias; const float* ssm_A_log; const float* ssm_D; const float* ssm_norm_w;
    const float* dn_conv_w; const float* dn_conv_b; const float* dn_dt_bias; const float* dn_A_log; const float* dn_norm_w;
    const float* ln_g; const float* ln_b;
    float* out; unsigned char* ws;
    int ph_lo, ph_hi;
};

__device__ __forceinline__ bf16_t f2bf(float f) { unsigned u = __float_as_uint(f); u += 0x7fffu + ((u >> 16) & 1u); return (bf16_t)(u >> 16); }
__device__ __forceinline__ float bf2f(bf16_t h) { return __uint_as_float(((unsigned)h) << 16); }
typedef float f32x2_t __attribute__((ext_vector_type(2)));
typedef __bf16 bf16x2_t __attribute__((ext_vector_type(2)));
__device__ __forceinline__ unsigned pack2(float a, float b) { f32x2_t v = {a, b}; bf16x2_t r = __builtin_convertvector(v, bf16x2_t); return __builtin_bit_cast(unsigned, r); }
__device__ __forceinline__ float lo2f(unsigned u) { return __uint_as_float(u << 16); }
__device__ __forceinline__ float hi2f(unsigned u) { return __uint_as_float(u & 0xffff0000u); }
__device__ __forceinline__ float silu_f(float x) { return x / (1.f + __expf(-x)); }
__device__ __forceinline__ float softplus_f(float x) { return x > 20.f ? x : log1pf(__expf(x)); }
__device__ __forceinline__ f32x4 mfma16(bf16x8 a, bf16x8 b, f32x4 c) { return __builtin_amdgcn_mfma_f32_16x16x32_bf16(a, b, c, 0, 0, 0); }
__device__ __forceinline__ void unpack8(uint4 v, float* f) {
    f[0] = lo2f(v.x); f[1] = hi2f(v.x); f[2] = lo2f(v.y); f[3] = hi2f(v.y); f[4] = lo2f(v.z); f[5] = hi2f(v.z); f[6] = lo2f(v.w); f[7] = hi2f(v.w);
}
__device__ __forceinline__ uint4 pack8(const float* f) { uint4 v; v.x = pack2(f[0], f[1]); v.y = pack2(f[2], f[3]); v.z = pack2(f[4], f[5]); v.w = pack2(f[6], f[7]); return v; }
__device__ __forceinline__ float wave_incl_scan(float x, int lane) {
#pragma unroll
    for (int o = 1; o < 64; o <<= 1) { float y = __shfl_up(x, o); if (lane >= o) x += y; }
    return x;
}

__device__ __forceinline__ int opaque_tid() { int t = threadIdx.x; asm volatile("" : "+v"(t)); return t; }
__device__ __forceinline__ void grid_barrier(unsigned* bar, unsigned target) {
    asm volatile("s_waitcnt vmcnt(0)" ::: "memory");
    __syncthreads();
    if (threadIdx.x == 0) {
        __builtin_amdgcn_fence(__ATOMIC_RELEASE, "agent");
        asm volatile("s_waitcnt vmcnt(0)" ::: "memory");
        __hip_atomic_fetch_add(bar, 1u, __ATOMIC_RELAXED, __HIP_MEMORY_SCOPE_AGENT);
        while (__hip_atomic_load(bar, __ATOMIC_RELAXED, __HIP_MEMORY_SCOPE_AGENT) < target) __builtin_amdgcn_s_sleep(2);
        __builtin_amdgcn_fence(__ATOMIC_ACQUIRE, "agent");
        asm volatile("s_waitcnt vmcnt(0)" ::: "memory");
    }
    __syncthreads();
}
#define XB_TMO      128
#define XB_XCNT(j)  (256  + 64 * (j))
#define XB_XSUB(j)  (1280 + 64 * (j))
#define XB_XGEN(j)  (2304 + 64 * (j))
#define XB_TOP      3328
#define XB_TOPGEN   3392
#define XCD_BAR_WORDS 3456
#define XB_SPIN_CAP (1u << 18)
#define LAS __attribute__((address_space(3)))

__device__ __forceinline__ unsigned xb_ld(unsigned* p)              { return __hip_atomic_load(p, __ATOMIC_RELAXED, __HIP_MEMORY_SCOPE_AGENT); }
__device__ __forceinline__ unsigned xb_add(unsigned* p, unsigned v) { return __hip_atomic_fetch_add(p, v, __ATOMIC_RELAXED, __HIP_MEMORY_SCOPE_AGENT); }
__device__ __forceinline__ unsigned xb_xcc_id() { return (unsigned)__builtin_amdgcn_s_getreg((3 << 11) | 20) & 0xFu; }
#define XB_SPIN(cond, bar) do { unsigned _sp = 0; while (cond) { __builtin_amdgcn_s_sleep(1); \
    if ((++_sp & 255u) == 0u) { if (xb_ld(&(bar)[XB_TMO])) break; if (_sp > XB_SPIN_CAP) { atomicAdd(&(bar)[XB_TMO], 1u); break; } } } } while (0)

struct XcdBarrier {
    unsigned* bar; unsigned x;
    volatile LAS unsigned* st;
};

__device__ __forceinline__ XcdBarrier xcd_barrier_post(unsigned* bar, volatile LAS unsigned* st) {
    XcdBarrier b; b.bar = bar; b.x = xb_xcc_id(); b.st = st;
    if (threadIdx.x == 0) (void)xb_add(&bar[XB_XCNT(b.x)], 1u);
    return b;
}
__device__ __forceinline__ void xcd_barrier_complete(unsigned* bar, unsigned x, unsigned& nloc, unsigned& nx) {
    const unsigned G = gridDim.x * gridDim.y * gridDim.z;
    unsigned sum, cnt, mine, sp = 0u;
    for (;;) {
        sum = 0u; cnt = 0u; mine = 0u;
#pragma unroll
        for (unsigned j = 0; j < 16; ++j) { const unsigned c = xb_ld(&bar[XB_XCNT(j)]); sum += c; cnt += (c > 0u) ? 1u : 0u; mine = (j == x) ? c : mine; }
        if (sum == G) break;
        __builtin_amdgcn_s_sleep(1);
        if ((++sp & 255u) == 0u) { if (xb_ld(&bar[XB_TMO])) break; if (sp > XB_SPIN_CAP) { atomicAdd(&bar[XB_TMO], 1u); break; } }
    }
    nloc = mine > 0u ? mine : 1u; nx = cnt > 0u ? cnt : 1u;
}

__device__ __forceinline__ void xcd_barrier(const XcdBarrier& b) {
    asm volatile("s_waitcnt vmcnt(0)" ::: "memory");
    __syncthreads();
    if (threadIdx.x == 0) {
        unsigned* bar = b.bar;
        __builtin_amdgcn_s_waitcnt(0);
        unsigned nloc = b.st[0], nx = b.st[1];
        if (nloc == 0u) { xcd_barrier_complete(bar, b.x, nloc, nx); b.st[0] = nloc; b.st[1] = nx; }
        const unsigned old = xb_add(&bar[XB_XSUB(b.x)], 1u);
        const unsigned gen = old / nloc;
        if (old + 1u == (gen + 1u) * nloc) {
            __builtin_amdgcn_fence(__ATOMIC_RELEASE, "agent");
            asm volatile("s_waitcnt vmcnt(0)" ::: "memory");
            const unsigned og = xb_add(&bar[XB_TOP], 1u);
            const unsigned tg = og / nx;
            if (og + 1u == (tg + 1u) * nx) xb_add(&bar[XB_TOPGEN], 1u);
            else XB_SPIN(xb_ld(&bar[XB_TOPGEN]) == tg, bar);
            __builtin_amdgcn_fence(__ATOMIC_ACQUIRE, "agent");
            xb_add(&bar[XB_XGEN(b.x)], 1u);
            asm volatile("s_waitcnt vmcnt(0)" ::: "memory");
        } else {
            XB_SPIN(xb_ld(&bar[XB_XGEN(b.x)]) == gen, bar);
            __builtin_amdgcn_fence(__ATOMIC_ACQUIRE, "agent");
            asm volatile("s_waitcnt vmcnt(0)" ::: "memory");
        }
    }
    __syncthreads();
}

__device__ __forceinline__ int next_unit(unsigned* ctr, int* s_unit) {
    __syncthreads();
    if (threadIdx.x == 0) *s_unit = (int)atomicAdd(ctr, 1u);
    __syncthreads();
    return *s_unit;
}

struct ConvW { float w[4][8]; float b[8]; };
__device__ __forceinline__ void load_convw(ConvW& cw, const float* W, const float* B, int C, int ch0) {
#pragma unroll
    for (int i = 0; i < 4; ++i)
#pragma unroll
        for (int e = 0; e < 8; ++e) cw.w[i][e] = W[i * C + ch0 + e];
#pragma unroll
    for (int e = 0; e < 8; ++e) cw.b[e] = B[ch0 + e];
}
__device__ __forceinline__ void conv_acc(const ConvW& cw, int tap, uint4 raw, float* acc) {
    float f[8]; unpack8(raw, f);
#pragma unroll
    for (int e = 0; e < 8; ++e) acc[e] += cw.w[tap][e] * f[e];
}

__device__ __forceinline__ int win_src_col(int n) {
    if (n < 2816) return n;
    if (n < 5888) return n + 6;
    if (n < 5894) return 2816 + (n - 5888);
    if (n < 5906) return n;
    return -1;
}
__device__ void conv_win_unit(const Params& p, int layer, int u4) {
    const int tid = opaque_tid(), nl = tid & 63, kq = tid >> 6;
    const int u = u4 >> 2, part = u4 & 3;
    const int n = u * 64 + nl; const int src = win_src_col(n);
    const float* W = p.w_in + (size_t)layer * 1024 * INC;
    bf16_t* dst = (bf16_t*)(p.ws + WS_WINT) + (size_t)n * 1024;
#pragma unroll 2
    for (int k0 = part * 256 + kq * 64; k0 < part * 256 + kq * 64 + 64; k0 += 8) {
        float f[8];
#pragma unroll
        for (int e = 0; e < 8; ++e) f[e] = src >= 0 ? W[(size_t)(k0 + e) * INC + src] : 0.f;
        *(uint4*)(dst + k0) = pack8(f);
    }
}
__device__ void conv_wout_unit(const Params& p, int u4) {
    const int tid = opaque_tid(), nl = tid & 63, kq = tid >> 6;
    const int u = u4 >> 2, part = u4 & 3;
    const int layer = u >> 4; const int n = (u & 15) * 64 + nl;
    const float* W = p.w_out + (size_t)layer * DMIX * 1024;
    bf16_t* dst = (bf16_t*)(p.ws + WS_WOUTT) + (size_t)layer * 1024 * DMIX + (size_t)n * DMIX;
#pragma unroll 2
    for (int k0 = part * 384 + kq * 96; k0 < part * 384 + kq * 96 + 96; k0 += 8) {
        float f[8];
#pragma unroll
        for (int e = 0; e < 8; ++e) f[e] = W[(size_t)(k0 + e) * 1024 + n];
        *(uint4*)(dst + k0) = pack8(f);
    }
}

template <int MODE>
__device__ void gemm_unit(const Params& p, int layer, int tm, int tn, unsigned char* smem, bool nostore = false) {
    const int tid = opaque_tid(), lane = tid & 63, w = tid >> 6, wr = w >> 1, wc = w & 1, fr = lane & 15, g = lane >> 4;
    constexpr int K = MODE == 0 ? 1024 : 1536;
    constexpr int NK = K / 64;
    bf16_t* As = (bf16_t*)smem;
    bf16_t* Bs = As + 2 * 128 * 72;
    const bf16_t* Bt = MODE == 0 ? (const bf16_t*)(p.ws + WS_WINT) : (const bf16_t*)(p.ws + WS_WOUTT) + (size_t)layer * 1024 * DMIX;
    const bf16_t* P = MODE == 0 ? (const bf16_t*)(p.ws + WS_XB) : (const bf16_t*)(p.ws + WS_P);
    constexpr int LDA = MODE == 0 ? 1024 : LDP;

    f32x4 acc[4][4];
#pragma unroll
    for (int i = 0; i < 4; ++i)
#pragma unroll
        for (int j = 0; j < 4; ++j) acc[i][j] = (f32x4){0.f, 0.f, 0.f, 0.f};

    uint4 rab0, rab1, rab2, rab3, rb0, rb1, rb2, rb3;
    const bool vt = (MODE == 0) && (tn >= 6) && (tn <= 8);
    const int ra = vt ? wc : wr, rb = vt ? wr : wc;
    const int row8 = tid >> 3, kq8 = tid & 7;
    const bf16_t* Ag = P + (size_t)(tm * 128 + row8) * LDA + kq8 * 8;
    const bf16_t* Bg = Bt + (size_t)(tn * 128 + row8) * K + kq8 * 8;
    const int ldsw = row8 * 72 + kq8 * 8;
#define GEMM_LOAD(kt_) do { \
        int col_; \
        if (MODE == 0) col_ = (kt_) * 64; \
        else { const int kk0_ = (kt_) * 64; const int seg_ = kk0_ / 384; \
            const int segb_ = seg_ == 0 ? C_AG : (seg_ == 1 ? C_SZ : (seg_ == 2 ? C_CG : C_DG)); col_ = segb_ + (kk0_ - seg_ * 384); } \
        rab0 = *(const uint4*)(Ag + col_); rab1 = *(const uint4*)(Ag + (size_t)32 * LDA + col_); \
        rab2 = *(const uint4*)(Ag + (size_t)64 * LDA + col_); rab3 = *(const uint4*)(Ag + (size_t)96 * LDA + col_); \
        rb0 = *(const uint4*)(Bg + (kt_) * 64); rb1 = *(const uint4*)(Bg + (size_t)32 * K + (kt_) * 64); \
        rb2 = *(const uint4*)(Bg + (size_t)64 * K + (kt_) * 64); rb3 = *(const uint4*)(Bg + (size_t)96 * K + (kt_) * 64); } while (0)
#define GEMM_STORE(buf_) do { \
        bf16_t* a_ = As + (buf_) * 128 * 72 + ldsw; bf16_t* b_ = Bs + (buf_) * 128 * 72 + ldsw; \
        *(uint4*)(a_) = rab0; *(uint4*)(a_ + 32 * 72) = rab1; *(uint4*)(a_ + 64 * 72) = rab2; *(uint4*)(a_ + 96 * 72) = rab3; \
        *(uint4*)(b_) = rb0; *(uint4*)(b_ + 32 * 72) = rb1; *(uint4*)(b_ + 64 * 72) = rb2; *(uint4*)(b_ + 96 * 72) = rb3; } while (0)
#define GEMM_COMPUTE(buf_) do { \
        const bf16_t* a_ = (vt ? Bs : As) + (buf_) * 128 * 72; const bf16_t* b_ = (vt ? As : Bs) + (buf_) * 128 * 72; \
        _Pragma("unroll") for (int ks = 0; ks < 2; ++ks) { \
            bf16x8 af[4], bfr[4]; \
            _Pragma("unroll") for (int mt = 0; mt < 4; ++mt) af[mt] = *(const bf16x8*)(a_ + (ra * 64 + mt * 16 + fr) * 72 + ks * 32 + g * 8); \
            _Pragma("unroll") for (int nt = 0; nt < 4; ++nt) bfr[nt] = *(const bf16x8*)(b_ + (rb * 64 + nt * 16 + fr) * 72 + ks * 32 + g * 8); \
            _Pragma("unroll") for (int mt = 0; mt < 4; ++mt) \
                _Pragma("unroll") for (int nt = 0; nt < 4; ++nt) acc[mt][nt] = mfma16(bfr[nt], af[mt], acc[mt][nt]); \
        } } while (0)

    __syncthreads();
    GEMM_LOAD(0); GEMM_STORE(0);
    __syncthreads();
#pragma unroll 1
    for (int kt = 0; kt < NK - 1; ++kt) {
        const int buf = kt & 1;
        GEMM_LOAD(kt + 1);
        __builtin_amdgcn_sched_barrier(0);
        GEMM_COMPUTE(buf);
        __builtin_amdgcn_sched_barrier(0);
        GEMM_STORE(buf ^ 1);
        __syncthreads();
    }
    GEMM_COMPUTE((NK - 1) & 1);
#undef GEMM_LOAD
#undef GEMM_STORE
#undef GEMM_COMPUTE
    if (nostore && acc[0][0][0] != 12345.678f) return;
    if (MODE == 0) {
        bf16_t* Pw = (bf16_t*)(p.ws + WS_P); float* SM = (float*)(p.ws + WS_SM); bf16_t* halo = (bf16_t*)(p.ws + WS_HALO);
#pragma unroll
        for (int mt = 0; mt < 4; ++mt) {
            const int row = tm * 128 + wr * 64 + mt * 16 + fr;
#pragma unroll
            for (int nt = 0; nt < 4; ++nt) {
                const int col0 = tn * 128 + wc * 64 + nt * 16 + g * 4; const f32x4 v = acc[mt][nt];
                if (vt) {
                    const int n = tn * 128 + wc * 64 + mt * 16 + fr; const int t = tm * 128 + wr * 64 + nt * 16 + g * 4;
                    uint2 o; o.x = pack2(v[0], v[1]); o.y = pack2(v[2], v[3]);
                    *(uint2*)(Pw + (size_t)((t & ~63) + (n & 63)) * LDP + (n & ~63) + (t & 63)) = o;
                } else if (tn < 46) {
                    uint2 o; o.x = pack2(v[0], v[1]); o.y = pack2(v[2], v[3]);
                    *(uint2*)(Pw + (size_t)row * LDP + col0) = o;
                    if (col0 >= C_DQ && col0 < C_DG && (row & 63) >= 61)
                        *(uint2*)(halo + (size_t)((row >> 6) * 3 + (row & 63) - 61) * 1152 + (col0 - C_DQ)) = o;
                } else {
#pragma unroll
                    for (int j = 0; j < 4; ++j) { const int c = col0 - 5888 + j; if (c < 18) SM[(size_t)row * 32 + c] = v[j]; }
                }
            }
        }
    } else {
        const float* resid = (layer == 0) ? p.x : p.out;
#pragma unroll
        for (int mt = 0; mt < 4; ++mt) {
            const int row = tm * 128 + wr * 64 + mt * 16 + fr;
#pragma unroll
            for (int nt = 0; nt < 4; ++nt) {
                const int col0 = tn * 128 + wc * 64 + nt * 16 + g * 4; const f32x4 v = acc[mt][nt];
                const float4 r = *(const float4*)(resid + (size_t)row * 1024 + col0);
                float4 o; o.x = DN_ALPHA * r.x + v[0]; o.y = DN_ALPHA * r.y + v[1]; o.z = DN_ALPHA * r.z + v[2]; o.w = DN_ALPHA * r.w + v[3];
                *(float4*)(p.out + (size_t)row * 1024 + col0) = o;
            }
        }
    }
}

__device__ void ln_unit(const Params& p, int layer, int u) {
    const int tid = opaque_tid(), lane = tid & 63, w = tid >> 6;
    const float* G = p.ln_g + layer * 1024; const float* Bb = p.ln_b + layer * 1024;
#pragma unroll 4
    for (int i = 0; i < 8; ++i) {
        float* row = p.out + (size_t)(u * 32 + w * 8 + i) * 1024;
        float4 v[4]; float s = 0.f;
#pragma unroll
        for (int c = 0; c < 4; ++c) { v[c] = *(const float4*)(row + c * 256 + lane * 4); s += (v[c].x + v[c].y) + (v[c].z + v[c].w); }
#pragma unroll
        for (int o = 32; o >= 1; o >>= 1) s += __shfl_xor(s, o);
        const float mu = s * (1.f / 1024.f); float q = 0.f;
#pragma unroll
        for (int c = 0; c < 4; ++c) { float a = v[c].x - mu, b = v[c].y - mu, cc = v[c].z - mu, d = v[c].w - mu; q += (a * a + b * b) + (cc * cc + d * d); }
#pragma unroll
        for (int o = 32; o >= 1; o >>= 1) q += __shfl_xor(q, o);
        const float rstd = rsqrtf(q * (1.f / 1024.f) + 1e-5f);
#pragma unroll
        for (int c = 0; c < 4; ++c) {
            const float4 gg = *(const float4*)(G + c * 256 + lane * 4); const float4 bb = *(const float4*)(Bb + c * 256 + lane * 4);
            float4 o; o.x = (v[c].x - mu) * rstd * gg.x + bb.x; o.y = (v[c].y - mu) * rstd * gg.y + bb.y; o.z = (v[c].z - mu) * rstd * gg.z + bb.z; o.w = (v[c].w - mu) * rstd * gg.w + bb.w;
            *(float4*)(row + c * 256 + lane * 4) = o;
            if (layer == 0) { uint2 xb; xb.x = pack2(o.x, o.y); xb.y = pack2(o.z, o.w); *(uint2*)((bf16_t*)(p.ws + WS_XB) + (size_t)(u * 32 + w * 8 + i) * 1024 + c * 256 + lane * 4) = xb; }
        }
    }
}
__device__ void conv_x_unit(const Params& p, int u) {
    const int tid = opaque_tid(), lane = tid & 63, w = tid >> 6;
#pragma unroll 4
    for (int i = 0; i < 8; ++i) {
        const size_t r = (size_t)(u * 32 + w * 8 + i) * 1024;
#pragma unroll
        for (int c = 0; c < 4; ++c) { const float4 v = *(const float4*)(p.x + r + c * 256 + lane * 4); uint2 xb; xb.x = pack2(v.x, v.y); xb.y = pack2(v.z, v.w); *(uint2*)((bf16_t*)(p.ws + WS_XB) + r + c * 256 + lane * 4) = xb; }
    }
}

__device__ void kmean_unit(const Params& p, int u, unsigned char* smem) {
    const int tid = opaque_tid(); const int b = u >> 5, blk = u & 31;
    float* red = (float*)smem;
    const int cgp = tid % 48, rg = tid / 48;
    __syncthreads();
    if (rg < 5) {
        const bf16_t* P = (const bf16_t*)(p.ws + WS_P) + (size_t)(b * SEQ + blk * 256) * LDP + C_AK + cgp * 8;
        float acc[8];
#pragma unroll
        for (int e = 0; e < 8; ++e) acc[e] = 0.f;
#pragma unroll 4
        for (int r = rg; r < 256; r += 5) { float f[8]; unpack8(*(const uint4*)(P + (size_t)r * LDP), f);
#pragma unroll
            for (int e = 0; e < 8; ++e) acc[e] += f[e]; }
#pragma unroll
        for (int e = 0; e < 8; ++e) red[rg * 384 + cgp * 8 + e] = acc[e];
    }
    __syncthreads();
    for (int col = tid; col < 384; col += 256) {
        const float sm = (red[col] + red[384 + col]) + (red[768 + col] + red[1152 + col]) + red[1536 + col];
        const int h = col >> 6, d = col & 63;
        ((float*)(p.ws + WS_KMEAN))[((size_t)(b * 6 + h) * 32 + blk) * 64 + d] = sm * (1.f / 256.f);
    }
}

struct AttnSt { f32x4 o[4]; float m, l; };

template <int NMT, int VS, class F>
__device__ __forceinline__ void attn_tile_g(AttnSt& st, const bf16x8 (&qf)[2], const bf16_t* Kl, const bf16_t* Vt, int lane, F score) {
    const int fr = lane & 15, g = lane >> 4;
    f32x4 s[NMT];
#pragma unroll
    for (int mt = 0; mt < NMT; ++mt) {
        s[mt] = (f32x4){0.f, 0.f, 0.f, 0.f};
#pragma unroll
        for (int ks = 0; ks < 2; ++ks) {
            const bf16x8 a = *(const bf16x8*)(Kl + (mt * 16 + fr) * 72 + ks * 32 + g * 8);
            s[mt] = mfma16(a, qf[ks], s[mt]);
        }
    }
    float mx = -1e30f;
#pragma unroll
    for (int mt = 0; mt < NMT; ++mt)
#pragma unroll
        for (int j = 0; j < 4; ++j) { const float v = score(mt * 16 + g * 4 + j, s[mt][j]); s[mt][j] = v; mx = fmaxf(mx, v); }
    mx = fmaxf(mx, __shfl_xor(mx, 16)); mx = fmaxf(mx, __shfl_xor(mx, 32));
    const float mn = fmaxf(st.m, mx); const float alpha = __expf(st.m - mn);
    float ps = 0.f;
#pragma unroll
    for (int mt = 0; mt < NMT; ++mt)
#pragma unroll
        for (int j = 0; j < 4; ++j) { const float pv = s[mt][j] > -1e29f ? __expf(s[mt][j] - mn) : 0.f; s[mt][j] = pv; ps += pv; }
    ps += __shfl_xor(ps, 16); ps += __shfl_xor(ps, 32);
    st.l = st.l * alpha + ps; st.m = mn;
#pragma unroll
    for (int mt = 0; mt < 4; ++mt) st.o[mt] = st.o[mt] * alpha;
#pragma unroll
    for (int k2 = 0; k2 < NMT / 2; ++k2) {
        union { bf16x8 v; unsigned u[4]; } pbu;
        pbu.u[0] = pack2(s[2 * k2][0], s[2 * k2][1]); pbu.u[1] = pack2(s[2 * k2][2], s[2 * k2][3]);
        pbu.u[2] = pack2(s[2 * k2 + 1][0], s[2 * k2 + 1][1]); pbu.u[3] = pack2(s[2 * k2 + 1][2], s[2 * k2 + 1][3]);
        const bf16x8 pb = pbu.v;
#pragma unroll
        for (int mt = 0; mt < 4; ++mt) {
            const bf16x4 lo = *(const bf16x4*)(Vt + (mt * 16 + fr) * VS + k2 * 32 + g * 4);
            const bf16x4 hi = *(const bf16x4*)(Vt + (mt * 16 + fr) * VS + k2 * 32 + 16 + g * 4);
            bf16x8 a; a[0] = lo[0]; a[1] = lo[1]; a[2] = lo[2]; a[3] = lo[3]; a[4] = hi[0]; a[5] = hi[1]; a[6] = hi[2]; a[7] = hi[3];
            st.o[mt] = mfma16(a, pb, st.o[mt]);
        }
    }
}
template <class F>
__device__ __forceinline__ void attn_tile(AttnSt& st, const bf16x8 (&qf)[2], const bf16_t* Kl, const bf16_t* Vt, int lane, F score) {
    attn_tile_g<4, 72>(st, qf, Kl, Vt, lane, score);
}

__device__ __forceinline__ void attn_tile_past128(AttnSt& st, const bf16x8 (&qf)[2], const bf16_t* Kl, const bf16_t* Vt, int lane, float base2, float slope2) {
    const int fr = lane & 15, g = lane >> 4;
    constexpr float C2 = 0.125f * 1.4426950408889634f;
    f32x4 s[8];
#pragma unroll
    for (int mt = 0; mt < 8; ++mt) {
        s[mt] = (f32x4){0.f, 0.f, 0.f, 0.f};
#pragma unroll
        for (int ks = 0; ks < 2; ++ks) {
            const bf16x8 a = *(const bf16x8*)(Kl + (mt * 16 + fr) * 72 + ks * 32 + g * 8);
            s[mt] = mfma16(a, qf[ks], s[mt]);
        }
    }
    float mx = -1e30f;
#pragma unroll
    for (int mt = 0; mt < 8; ++mt)
#pragma unroll
        for (int j = 0; j < 4; ++j) { const float v = fmaf(s[mt][j], C2, fmaf(slope2, (float)(mt * 16 + j), base2)); s[mt][j] = v; mx = fmaxf(mx, v); }
    mx = fmaxf(mx, __shfl_xor(mx, 16)); mx = fmaxf(mx, __shfl_xor(mx, 32));
    const float mn = fmaxf(st.m, mx); const float alpha = exp2f(st.m - mn);
    float ps = 0.f;
#pragma unroll
    for (int mt = 0; mt < 8; ++mt)
#pragma unroll
        for (int j = 0; j < 4; ++j) { const float pv = __builtin_amdgcn_exp2f(s[mt][j] - mn); s[mt][j] = pv; ps += pv; }
    ps += __shfl_xor(ps, 16); ps += __shfl_xor(ps, 32);
    st.l = st.l * alpha + ps; st.m = mn;
#pragma unroll
    for (int mt = 0; mt < 4; ++mt) st.o[mt] = st.o[mt] * alpha;
#pragma unroll
    for (int k2 = 0; k2 < 4; ++k2) {
        union { bf16x8 v; unsigned u[4]; } pbu;
        pbu.u[0] = pack2(s[2 * k2][0], s[2 * k2][1]); pbu.u[1] = pack2(s[2 * k2][2], s[2 * k2][3]);
        pbu.u[2] = pack2(s[2 * k2 + 1][0], s[2 * k2 + 1][1]); pbu.u[3] = pack2(s[2 * k2 + 1][2], s[2 * k2 + 1][3]);
        const bf16x8 pb = pbu.v;
#pragma unroll
        for (int mt = 0; mt < 4; ++mt) {
            const bf16x4 lo = *(const bf16x4*)(Vt + (mt * 16 + fr) * 136 + k2 * 32 + g * 4);
            const bf16x4 hi = *(const bf16x4*)(Vt + (mt * 16 + fr) * 136 + k2 * 32 + 16 + g * 4);
            bf16x8 a; a[0] = lo[0]; a[1] = lo[1]; a[2] = lo[2]; a[3] = lo[3]; a[4] = hi[0]; a[5] = hi[1]; a[6] = hi[2]; a[7] = hi[3];
            st.o[mt] = mfma16(a, pb, st.o[mt]);
        }
    }
}

template <class TF>
__device__ __forceinline__ void stage_kv(const bf16_t* P, int colK, int colV, bf16_t* Kl, bf16_t* Vt, TF tokfn) {
    const int tid = opaque_tid(), cgp = tid & 7;
#pragma unroll
    for (int i = 0; i < 2; ++i) {
        const int krow = (tid >> 3) + 32 * i; const int tok = tokfn(krow);
        uint4 kv = make_uint4(0, 0, 0, 0), vv = make_uint4(0, 0, 0, 0);
        if (tok >= 0) { kv = *(const uint4*)(P + (size_t)tok * LDP + colK + cgp * 8); vv = *(const uint4*)(P + (size_t)tok * LDP + colV + cgp * 8); }
        *(uint4*)(Kl + krow * 72 + cgp * 8) = kv;
        bf16_t* vt = Vt + (cgp * 8) * 72 + krow;
        vt[0 * 72] = (bf16_t)(vv.x & 0xffff); vt[1 * 72] = (bf16_t)(vv.x >> 16); vt[2 * 72] = (bf16_t)(vv.y & 0xffff); vt[3 * 72] = (bf16_t)(vv.y >> 16);
        vt[4 * 72] = (bf16_t)(vv.z & 0xffff); vt[5 * 72] = (bf16_t)(vv.z >> 16); vt[6 * 72] = (bf16_t)(vv.w & 0xffff); vt[7 * 72] = (bf16_t)(vv.w >> 16);
    }
}

__device__ void moba_unit(const Params& p, int xq, int u, unsigned char* smem, bool dry = false) {
    const int tid = opaque_tid(), lane = tid & 63, w = tid >> 6, fr = lane & 15, g = lane >> 4;
    const int ob = 31 - u / 3; const int strm = 3 * xq + u % 3; const int bh = strm >> 1, hb = strm & 1; const int b = bh / 6, h = bh % 6;
    const int tb = ob * 256 + hb * 128;
    bf16_t* P = (bf16_t*)(p.ws + WS_P);
    bf16_t* Kl = (bf16_t*)smem;
    bf16_t* Vt = (bf16_t*)(smem + 18432);
    float* STO = (float*)(smem + 35840);
    float* kml = STO;
    float* sc = STO + 32 * 64;
    float* STM = (float*)(smem + 68608); float* STL = STM + 128;
    unsigned* selm = (unsigned*)(smem + 69632);
    unsigned* cnt = selm + 128;
    unsigned* off = cnt + 32;
    unsigned* cur = off + 40;
    unsigned* steps = cur + 32;
    int* nstp = (int*)(steps + 96);
    unsigned short* list = (unsigned short*)(steps + 98);
    const float slope = exp2f(-8.f * (float)(7 + h) / 12.f);
    const int cgp = tid & 7, row0 = tid >> 3;
    const int nown = hb + 1;
    const bf16_t* Qg = P + (size_t)(b * SEQ + tb) * LDP + C_AQ + h * 64;
    __syncthreads();
    {
        const float* km = (const float*)(p.ws + WS_KMEAN) + (size_t)(b * 6 + h) * 32 * 64;
        for (int i = tid; i < ob * 64; i += 256) kml[i] = km[i];
    }
    if (tid < 32) cnt[tid] = 0u;
    {
        const int q = tid >> 1, part = tid & 1;
        float qv[64];
#pragma unroll
        for (int e = 0; e < 8; ++e) unpack8(*(const uint4*)(Qg + (size_t)q * LDP + e * 8), qv + e * 8);
        __syncthreads();
        for (int j = part; j < ob; j += 2) {
            float a0 = 0.f;
#pragma unroll
            for (int d = 0; d < 64; ++d) a0 += qv[d] * kml[j * 64 + d];
            sc[q * 33 + j] = a0;
        }
    }
    __syncthreads();
    if (tid < 128) {
        unsigned mask = 0; const int nsel = ob < 3 ? ob : 3;
        for (int r = 0; r < nsel; ++r) {
            float best = 0.f; int bi = -1;
            for (int j = 0; j < ob; ++j) if (!((mask >> j) & 1u)) { const float sv = sc[tid * 33 + j]; if (bi < 0 || sv > best) { best = sv; bi = j; } }
            mask |= 1u << bi; atomicAdd(&cnt[bi], 1u);
        }
        selm[tid] = mask;
    }
    __syncthreads();
    if (tid == 0) {
        unsigned o = 0; int ns = 0;
        for (unsigned r = 0; r < 2; ++r) for (int sb = 0; sb < nown; ++sb) steps[ns++] = 1u | ((unsigned)sb << 1) | (r << 8) | ((unsigned)(ob * 2 + sb) << 16);
        for (int j = 0; j < ob; ++j) {
            const unsigned c = cnt[j]; off[j] = o; cur[j] = o; o += c;
            for (unsigned r = 0; r * 64 < c; ++r)
                for (int sb = 0; sb < 2; ++sb) steps[ns++] = ((unsigned)sb << 1) | ((unsigned)j << 3) | (r << 8) | ((unsigned)(j * 2 + sb) << 16);
        }
        off[ob] = o; *nstp = ns;
    }
    __syncthreads();
    if (tid < 128) {
        unsigned mask = selm[tid];
        while (mask) { const int j = __ffs((int)mask) - 1; mask &= mask - 1; const unsigned pos = atomicAdd(&cur[j], 1u); list[pos] = (unsigned short)tid; }
    }
    __syncthreads();
    const int nsteps = (PROBE == 12 && dry) ? 2 * nown : *nstp;
    uint4 k0, k1, k2, k3, v0, v1, v2, v3;
#define MB_LOAD(kb_) do { const bf16_t* pk_ = P + (size_t)(b * SEQ + (kb_) * 128 + row0) * LDP + h * 64 + cgp * 8; \
        k0 = *(const uint4*)(pk_ + C_AK); k1 = *(const uint4*)(pk_ + (size_t)32 * LDP + C_AK); k2 = *(const uint4*)(pk_ + (size_t)64 * LDP + C_AK); k3 = *(const uint4*)(pk_ + (size_t)96 * LDP + C_AK); \
        v0 = *(const uint4*)(pk_ + C_AV); v1 = *(const uint4*)(pk_ + (size_t)32 * LDP + C_AV); v2 = *(const uint4*)(pk_ + (size_t)64 * LDP + C_AV); v3 = *(const uint4*)(pk_ + (size_t)96 * LDP + C_AV); } while (0)
    MB_LOAD(steps[0] >> 16);
    AttnSt st0; bf16x8 qf0[2], qfn[2];
    int qidx = 0, qidx_n = 0; bool valid = false, wvalid = false, valid_n = false, wvalid_n = false;
    qfn[0] = (bf16x8){0, 0, 0, 0, 0, 0, 0, 0}; qfn[1] = qfn[0];
#pragma unroll 1
    for (int s_ = 0; s_ < nsteps; ++s_) {
        const unsigned stp = steps[s_];
        __syncthreads();
        *(uint4*)(Kl + row0 * 72 + cgp * 8) = k0; *(uint4*)(Kl + (row0 + 32) * 72 + cgp * 8) = k1;
        *(uint4*)(Kl + (row0 + 64) * 72 + cgp * 8) = k2; *(uint4*)(Kl + (row0 + 96) * 72 + cgp * 8) = k3;
        *(uint4*)(Vt + row0 * 136 + cgp * 8) = v0; *(uint4*)(Vt + (row0 + 32) * 136 + cgp * 8) = v1;
        *(uint4*)(Vt + row0 * 136 + 64 + cgp * 8) = v2; *(uint4*)(Vt + (row0 + 32) * 136 + 64 + cgp * 8) = v3;
        __syncthreads();
        if (s_ + 1 < nsteps) {
            const unsigned nst = steps[s_ + 1];
            MB_LOAD(nst >> 16);
            if (!(nst & 1u) && !((nst >> 1) & 1u)) {
                const int j = (nst >> 3) & 31; const int r = (nst >> 8) & 15;
                const int nj = (int)cnt[j]; const int ofs = (int)off[j];
                const int tpos = r * 64 + ((w - j - hb - 2 * (b * 6 + h)) & 3) * 16;
                wvalid_n = tpos < nj; valid_n = tpos + fr < nj;
                int idx = tpos + fr; if (idx > nj - 1) idx = nj - 1;
                qidx_n = (int)list[ofs + idx];
                const bf16_t* qp = Qg + (size_t)qidx_n * LDP + g * 8;
                qfn[0] = *(const bf16x8*)qp; qfn[1] = *(const bf16x8*)(qp + 32);
            }
        }
        __builtin_amdgcn_sched_barrier(0);
        const int sub = (stp >> 1) & 1; const int key0 = (int)(stp >> 16) * 128;
        if (stp & 1u) {
            const int ro = (stp >> 8) & 1;
            const int q0 = ro * 64 + w * 16 + fr;
            if (sub == 0) {
                st0.m = -1e30f; st0.l = 0.f;
#pragma unroll
                for (int mt = 0; mt < 4; ++mt) st0.o[mt] = (f32x4){0.f, 0.f, 0.f, 0.f};
                const bf16_t* qp0 = Qg + (size_t)q0 * LDP + g * 8;
                qf0[0] = *(const bf16x8*)qp0; qf0[1] = *(const bf16x8*)(qp0 + 32);
            }
            const int tq0 = tb + q0;
            attn_tile_g<8, 136>(st0, qf0, Kl, Vt, lane, [&](int key, float raw) { const int kp = key0 + key; return kp <= tq0 ? raw * 0.125f - slope * (float)(tq0 - kp) : -1e30f; });
            if (sub == nown - 1) {
#pragma unroll
                for (int mt = 0; mt < 4; ++mt) *(f32x4*)(STO + q0 * 64 + mt * 16 + g * 4) = st0.o[mt];
                if (g == 0) { STM[q0] = st0.m; STL[q0] = st0.l; }
            }
        } else {
            if (sub == 0) {
                qidx = qidx_n; valid = valid_n; wvalid = wvalid_n; qf0[0] = qfn[0]; qf0[1] = qfn[1];
                st0.m = -1e30f; st0.l = 0.f;
#pragma unroll
                for (int mt = 0; mt < 4; ++mt) st0.o[mt] = (f32x4){0.f, 0.f, 0.f, 0.f};
            }
            if (wvalid && !(PROBE == 13 && dry)) {
                const int tq = tb + qidx;
                const float slope2 = slope * 1.4426950408889634f;
                attn_tile_past128(st0, qf0, Kl, Vt, lane, -slope2 * (float)(tq - key0 - g * 4), slope2);
                if (sub == 1 && valid) {
                    const float mo = STM[qidx], lo = STL[qidx];
                    const float mblk = st0.m * 0.6931471805599453f;
                    const float mn = fmaxf(mo, mblk); const float ao = __expf(mo - mn), an = __expf(mblk - mn);
#pragma unroll
                    for (int mt = 0; mt < 4; ++mt) { f32x4* sp = (f32x4*)(STO + qidx * 64 + mt * 16 + g * 4); *sp = (*sp) * ao + st0.o[mt] * an; }
                    if (g == 0) { STM[qidx] = mn; STL[qidx] = lo * ao + st0.l * an; }
                }
            }
        }
    }
#undef MB_LOAD
    __syncthreads();
    {
        const int q = tid >> 1, hf = tid & 1;
        const float inv = 1.f / STL[q];
        bf16_t* gp = P + (size_t)(b * SEQ + tb + q) * LDP + C_AG + h * 64 + hf * 32;
        const float* so = STO + q * 64 + hf * 32;
#pragma unroll
        for (int e = 0; e < 4; ++e) {
            float gt[8], o[8]; unpack8(*(const uint4*)(gp + e * 8), gt);
#pragma unroll
            for (int k = 0; k < 8; ++k) o[k] = so[e * 8 + k] * inv * silu_f(gt[k]);
            if (!dry) *(uint4*)(gp + e * 8) = pack8(o);
        }
    }
}

__device__ void dil_unit(const Params& p, int cfg, int u, unsigned char* smem, bool dry = false) {
    const int tid = opaque_tid(), lane = tid & 63, w = tid >> 6, fr = lane & 15, g = lane >> 4;
    const int tl = u & 127; const int bh = u >> 7; const int b = bh / 6, h = bh % 6;
    const int d = cfg == 0 ? 1 : (cfg == 1 ? 4 : 16);
    const int tpc = 128 / d; const int r = tl / tpc, sub = tl % tpc; const int qi0 = sub * 64;
    bf16_t* P = (bf16_t*)(p.ws + WS_P);
    bf16_t* Kl = (bf16_t*)smem; bf16_t* Vt = Kl + 64 * 72;
    const float slope = exp2f(-8.f * (float)(h + 1) / 12.f) * (float)d;
    const int qi = qi0 + 16 * w + fr; const int tq = r + d * qi; const size_t tokq = (size_t)b * SEQ + tq;
    bf16x8 qf[2];
    {
        const bf16_t* qp = P + tokq * LDP + C_CQ + h * 64;
        qf[0] = *(const bf16x8*)(qp + g * 8); qf[1] = *(const bf16x8*)(qp + 32 + g * 8);
    }
    AttnSt st; st.m = -1e30f; st.l = 0.f;
#pragma unroll
    for (int mt = 0; mt < 4; ++mt) st.o[mt] = (f32x4){0.f, 0.f, 0.f, 0.f};
    for (int kt = 0; kt < 3; ++kt) {
        const int ki0 = qi0 - 128 + kt * 64;
        if (ki0 + 63 < 0) continue;
        __syncthreads();
        stage_kv(P, C_CK + h * 64, C_CV + h * 64, Kl, Vt, [&](int krow) { const int ki = ki0 + krow; return ki >= 0 ? b * SEQ + r + d * ki : -1; });
        __syncthreads();
        attn_tile(st, qf, Kl, Vt, lane, [&](int key, float raw) {
            const int ki = ki0 + key; const int df = qi - ki;
            const bool ok = (ki >= 0) && (df >= 0) && (df <= 128);
            return ok ? raw * 0.125f - slope * (float)df : -1e30f;
        });
    }
    const float inv = 1.f / st.l; const float lse = st.m + __logf(st.l);
    bf16_t* Op = (bf16_t*)(p.ws + WS_DILO) + tokq * 384 + h * 64;
    float* Lp = (float*)(p.ws + WS_DILL) + tokq * 8 + h;
    float wo = 0.f, wn = 1.f, Ln = lse;
    if (cfg > 0) {
        const float Lo = *Lp; const float mx = fmaxf(Lo, lse);
        Ln = mx + __logf(__expf(Lo - mx) + __expf(lse - mx));
        wo = __expf(Lo - Ln); wn = __expf(lse - Ln);
    }
    const bf16_t* gp = P + tokq * LDP + C_CG + h * 64;
#pragma unroll
    for (int mt = 0; mt < 4; ++mt) {
        const int dv = mt * 16 + g * 4;
        float o0 = st.o[mt][0] * inv * wn, o1 = st.o[mt][1] * inv * wn, o2 = st.o[mt][2] * inv * wn, o3 = st.o[mt][3] * inv * wn;
        if (cfg > 0) { const uint2 ov = *(const uint2*)(Op + dv); o0 += wo * lo2f(ov.x); o1 += wo * hi2f(ov.x); o2 += wo * lo2f(ov.y); o3 += wo * hi2f(ov.y); }
        if (cfg < 2) { uint2 o; o.x = pack2(o0, o1); o.y = pack2(o2, o3); if (!dry) *(uint2*)(Op + dv) = o; }
        else {
            const uint2 gv = *(const uint2*)(gp + dv); uint2 o;
            o.x = pack2(o0 * silu_f(lo2f(gv.x)), o1 * silu_f(hi2f(gv.x))); o.y = pack2(o2 * silu_f(lo2f(gv.y)), o3 * silu_f(hi2f(gv.y)));
            if (!dry) *(uint2*)((bf16_t*)gp + dv) = o;
        }
    }
    if (cfg < 2 && g == 0 && !dry) *Lp = Ln;
}

__device__ __forceinline__ void ssd_dt_acum(const Params& p, int layer, int tok0, int h, float* dtl, float* acum, int wsel = 0) {
    const int tid = opaque_tid() - wsel * 64, lane = tid & 63;
    const float* SM = (const float*)(p.ws + WS_SM);
    if (tid >= 0 && tid < 64) {
        const float bias = p.ssm_dt_bias[layer * 6 + h]; const float A = -__expf(p.ssm_A_log[layer * 6 + h]);
        const float d0 = softplus_f(SM[(size_t)(tok0 + 2 * lane) * 32 + h] + bias), d1 = softplus_f(SM[(size_t)(tok0 + 2 * lane + 1) * 32 + h] + bias);
        const float a0 = d0 * A, a1 = d1 * A;
        const float inc = wave_incl_scan(a0 + a1, lane);
        dtl[2 * lane] = d0; dtl[2 * lane + 1] = d1;
        acum[2 * lane] = inc - a1; acum[2 * lane + 1] = inc;
    }
}

__device__ __forceinline__ void ssd_conv8(const bf16_t* P, const ConvW& cw, int tok, int pos, int col, float* out) {
#pragma unroll
    for (int e = 0; e < 8; ++e) out[e] = cw.b[e];
#pragma unroll
    for (int i = 0; i < 4; ++i) {
        if (pos - 3 + i >= 0) conv_acc(cw, i, *(const uint4*)(P + (size_t)(tok - 3 + i) * LDP + col), out);
    }
#pragma unroll
    for (int e = 0; e < 8; ++e) out[e] = silu_f(out[e]);
}

__device__ void ssd_states_unit(const Params& p, int layer, int u, unsigned char* smem) {
    const int tid = opaque_tid(), lane = tid & 63, w = tid >> 6, fr = lane & 15, g = lane >> 4;
    const int grp = u & 1; const int bc = u >> 1; const int b = bc >> 6, c = bc & 63;
    const int tok0 = b * SEQ + c * 128; const int pos0 = c * 128;
    const bf16_t* P = (const bf16_t*)(p.ws + WS_P);
    bf16_t* BT = (bf16_t*)smem;
    bf16_t* XsT = BT + 128 * 136;
    float* dt3 = (float*)(smem + 52224); float* ac3 = dt3 + 3 * 128;
    const float* CW = p.ssm_conv_w + (size_t)layer * 4 * 896; const float* CB = p.ssm_conv_b + (size_t)layer * 896;
    __syncthreads();
    { const int wv = tid >> 6; if (wv < 3) ssd_dt_acum(p, layer, tok0, grp * 3 + wv, dt3 + wv * 128, ac3 + wv * 128, wv); }
    {
        const int cgp = tid & 15; ConvW cw; load_convw(cw, CW, CB, 896, 384 + grp * 128 + cgp * 8);
#pragma unroll 2
        for (int i = 0; i < 8; ++i) {
            const int l = (tid >> 4) + 16 * i; float o[8];
            ssd_conv8(P, cw, tok0 + l, pos0 + l, C_SB + grp * 128 + cgp * 8, o);
#pragma unroll
            for (int e = 0; e < 8; ++e) BT[(cgp * 8 + e) * 136 + l] = f2bf(o[e]);
        }
    }
    bf16_t* ST = (bf16_t*)(p.ws + WS_ST);
    for (int hh = 0; hh < 3; ++hh) {
        const int h = grp * 3 + hh;
        const float* dtl = dt3 + hh * 128; const float* acum = ac3 + hh * 128;
        __syncthreads();
        {
            const int cgp = tid & 7; ConvW cw; load_convw(cw, CW, CB, 896, h * 64 + cgp * 8);
            const float alast = acum[127];
            for (int i = 0; i < 4; ++i) {
                const int l = (tid >> 3) + 32 * i; float o[8];
                ssd_conv8(P, cw, tok0 + l, pos0 + l, C_SX + h * 64 + cgp * 8, o);
                const float sc = dtl[l] * __expf(alast - acum[l]);
#pragma unroll
                for (int e = 0; e < 8; ++e) XsT[(cgp * 8 + e) * 136 + l] = f2bf(o[e] * sc);
            }
            if (tid == 0) ((float*)(p.ws + WS_CDEC))[(size_t)(b * 64 + c) * 8 + h] = __expf(alast);
        }
        __syncthreads();
        f32x4 acc[2][4];
#pragma unroll
        for (int mt = 0; mt < 2; ++mt)
#pragma unroll
            for (int nt = 0; nt < 4; ++nt) acc[mt][nt] = (f32x4){0.f, 0.f, 0.f, 0.f};
#pragma unroll
        for (int ks = 0; ks < 4; ++ks) {
            bf16x8 a[2], bb[4];
#pragma unroll
            for (int mt = 0; mt < 2; ++mt) a[mt] = *(const bf16x8*)(BT + (32 * w + mt * 16 + fr) * 136 + ks * 32 + g * 8);
#pragma unroll
            for (int nt = 0; nt < 4; ++nt) bb[nt] = *(const bf16x8*)(XsT + (nt * 16 + fr) * 136 + ks * 32 + g * 8);
#pragma unroll
            for (int mt = 0; mt < 2; ++mt)
#pragma unroll
                for (int nt = 0; nt < 4; ++nt) acc[mt][nt] = mfma16(a[mt], bb[nt], acc[mt][nt]);
        }
        bf16_t* dst = ST + ((size_t)((b * 64 + c) * 6 + h)) * 8192;
#pragma unroll
        for (int mt = 0; mt < 2; ++mt)
#pragma unroll
            for (int nt = 0; nt < 4; ++nt) {
                const int n = 32 * w + mt * 16 + g * 4, pp = nt * 16 + fr;
                uint2 o; o.x = pack2(acc[mt][nt][0], acc[mt][nt][1]); o.y = pack2(acc[mt][nt][2], acc[mt][nt][3]);
                *(uint2*)(dst + pp * 128 + n) = o;
            }
    }
}

__device__ void ssd_scan_unit(const Params& p, int u) {
    const int gid = u * 256 + opaque_tid(); const int bh = gid >> 10, e8 = gid & 1023; const int b = bh / 6, h = bh % 6;
    bf16_t* ST = (bf16_t*)(p.ws + WS_ST); const float* CD = (const float*)(p.ws + WS_CDEC);
    float hr[8];
#pragma unroll
    for (int e = 0; e < 8; ++e) hr[e] = 0.f;
#pragma unroll 4
    for (int c = 0; c < 64; ++c) {
        bf16_t* a = ST + ((size_t)((b * 64 + c) * 6 + h)) * 8192 + e8 * 8;
        const uint4 v = *(const uint4*)a; float s[8]; unpack8(v, s);
        const float dec = CD[(size_t)(b * 64 + c) * 8 + h];
        *(uint4*)a = pack8(hr);
#pragma unroll
        for (int e = 0; e < 8; ++e) hr[e] = hr[e] * dec + s[e];
    }
}

__device__ void ssd_out_unit(const Params& p, int layer, int u, unsigned char* smem, bool dry = false) {
    const int tid = opaque_tid(), lane = tid & 63, w = tid >> 6, fr = lane & 15, g = lane >> 4;
    const int half = u & 1; const int bc = u >> 1; const int b = bc >> 6, c = bc & 63;
    const int tok0 = b * SEQ + c * 128; const int pos0 = c * 128; const int l0 = half * 64;
    bf16_t* P = (bf16_t*)(p.ws + WS_P);
    bf16_t* Ch = (bf16_t*)smem;
    bf16_t* Bb = Ch + 64 * 136;
    bf16_t* Gb = Bb + 64 * 136;
    bf16_t* XT = Gb + 64 * 136;
    float* red = (float*)(smem + 69632);
    float* dt6 = (float*)(smem + 71680);
    float* ac6 = dt6 + 6 * 128;
    const float* CW = p.ssm_conv_w + (size_t)layer * 4 * 896; const float* CB = p.ssm_conv_b + (size_t)layer * 896;
    const bf16_t* ST = (const bf16_t*)(p.ws + WS_ST);
    float ssq[4] = {0.f, 0.f, 0.f, 0.f};
    const int nsb = half + 1;
    __syncthreads();
    {
        const int wv = tid >> 6;
        ssd_dt_acum(p, layer, tok0, wv, dt6 + wv * 128, ac6 + wv * 128, wv);
        if (wv + 4 < 6) ssd_dt_acum(p, layer, tok0, wv + 4, dt6 + (wv + 4) * 128, ac6 + (wv + 4) * 128, wv);
    }
#pragma unroll 1
    for (int grp = 0; grp < 2; ++grp) {
        __syncthreads();
        {
            const int cgp = tid & 15; ConvW cw; load_convw(cw, CW, CB, 896, 640 + grp * 128 + cgp * 8);
#pragma unroll 1
            for (int i = 0; i < 4; ++i) {
                const int l = (tid >> 4) + 16 * i; float o[8];
                ssd_conv8(P, cw, tok0 + l0 + l, pos0 + l0 + l, C_SC + grp * 128 + cgp * 8, o);
                *(uint4*)(Ch + l * 136 + cgp * 8) = pack8(o);
            }
        }
        f32x4 G0[2][4];
#pragma unroll 1
        for (int sb = 0; sb < nsb; ++sb) {
            __syncthreads();
            {
                const int cgp = tid & 15; ConvW cw; load_convw(cw, CW, CB, 896, 384 + grp * 128 + cgp * 8);
#pragma unroll 1
                for (int i = 0; i < 4; ++i) {
                    const int s = (tid >> 4) + 16 * i; float o[8];
                    ssd_conv8(P, cw, tok0 + sb * 64 + s, pos0 + sb * 64 + s, C_SB + grp * 128 + cgp * 8, o);
                    *(uint4*)(Bb + s * 136 + cgp * 8) = pack8(o);
                }
            }
            __syncthreads();
            f32x4 acc[4];
#pragma unroll
            for (int nt = 0; nt < 4; ++nt) acc[nt] = (f32x4){0.f, 0.f, 0.f, 0.f};
#pragma unroll
            for (int ks = 0; ks < 4; ++ks) {
                const bf16x8 a = *(const bf16x8*)(Bb + (16 * w + fr) * 136 + ks * 32 + g * 8);
#pragma unroll
                for (int nt = 0; nt < 4; ++nt) { const bf16x8 bb = *(const bf16x8*)(Ch + (nt * 16 + fr) * 136 + ks * 32 + g * 8); acc[nt] = mfma16(a, bb, acc[nt]); }
            }
            if (sb == 0) {
#pragma unroll
                for (int nt = 0; nt < 4; ++nt) G0[0][nt] = acc[nt];
            } else {
#pragma unroll
                for (int nt = 0; nt < 4; ++nt) G0[1][nt] = acc[nt];
            }
        }
#pragma unroll 1
        for (int hh = 0; hh < 3; ++hh) {
            const int h = grp * 3 + hh;
            const float* dtl = dt6 + h * 128; const float* acum = ac6 + h * 128;
            __syncthreads();
#pragma unroll
            for (int sb = 0; sb < 2; ++sb) {
                if (sb < nsb) {
#pragma unroll
                    for (int nt = 0; nt < 4; ++nt) {
                        const int l = l0 + nt * 16 + fr; const float al = acum[l]; float v[4];
#pragma unroll
                        for (int j = 0; j < 4; ++j) { const int s = sb * 64 + 16 * w + g * 4 + j; v[j] = (s <= l) ? G0[sb][nt][j] * __expf(al - acum[s]) * dtl[s] : 0.f; }
                        uint2 o; o.x = pack2(v[0], v[1]); o.y = pack2(v[2], v[3]);
                        *(uint2*)(Gb + (nt * 16 + fr) * 136 + sb * 64 + 16 * w + g * 4) = o;
                    }
                }
            }
            {
                const int cgp = tid & 7; ConvW cw; load_convw(cw, CW, CB, 896, h * 64 + cgp * 8);
#pragma unroll 1
                for (int i = 0; i < 2 * nsb; ++i) {
                    const int s = (tid >> 3) + 32 * i; float o[8];
                    ssd_conv8(P, cw, tok0 + s, pos0 + s, C_SX + h * 64 + cgp * 8, o);
#pragma unroll
                    for (int e = 0; e < 8; ++e) XT[(cgp * 8 + e) * 136 + s] = f2bf(o[e]);
                }
            }
            {
                const bf16_t* src = ST + ((size_t)((b * 64 + c) * 6 + h)) * 8192;
#pragma unroll
                for (int i = 0; i < 4; ++i) { const int idx = tid + 256 * i; const int pp = idx >> 4, nq = idx & 15; *(uint4*)(Bb + pp * 136 + nq * 8) = *(const uint4*)(src + pp * 128 + nq * 8); }
            }
            __syncthreads();
            f32x4 a1[4], a2[4];
#pragma unroll
            for (int nt = 0; nt < 4; ++nt) { a1[nt] = (f32x4){0.f, 0.f, 0.f, 0.f}; a2[nt] = (f32x4){0.f, 0.f, 0.f, 0.f}; }
#pragma unroll
            for (int ks = 0; ks < 4; ++ks) {
                const bf16x8 a = *(const bf16x8*)(Bb + (16 * w + fr) * 136 + ks * 32 + g * 8);
#pragma unroll
                for (int nt = 0; nt < 4; ++nt) { const bf16x8 bb = *(const bf16x8*)(Ch + (nt * 16 + fr) * 136 + ks * 32 + g * 8); a1[nt] = mfma16(a, bb, a1[nt]); }
            }
#pragma unroll 1
            for (int ks = 0; ks < 2 * nsb; ++ks) {
                const bf16x8 a = *(const bf16x8*)(XT + (16 * w + fr) * 136 + ks * 32 + g * 8);
#pragma unroll
                for (int nt = 0; nt < 4; ++nt) { const bf16x8 bb = *(const bf16x8*)(Gb + (nt * 16 + fr) * 136 + ks * 32 + g * 8); a2[nt] = mfma16(a, bb, a2[nt]); }
            }
            const float Dh = p.ssm_D[layer * 6 + h];
#pragma unroll
            for (int nt = 0; nt < 4; ++nt) {
                const int l = nt * 16 + fr; const float ea = __expf(acum[l0 + l]);
                bf16_t* zp = P + (size_t)(tok0 + l0 + l) * LDP + C_SZ + h * 64 + 16 * w + g * 4;
                const uint2 zv = *(const uint2*)zp; float z[4] = {lo2f(zv.x), hi2f(zv.x), lo2f(zv.y), hi2f(zv.y)}; float y[4];
#pragma unroll
                for (int j = 0; j < 4; ++j) {
                    const float xs = bf2f(XT[(16 * w + g * 4 + j) * 136 + l0 + l]);
                    y[j] = (a1[nt][j] * ea + a2[nt][j] + Dh * xs) * silu_f(z[j]);
                    ssq[nt] += y[j] * y[j];
                }
                uint2 o; o.x = pack2(y[0], y[1]); o.y = pack2(y[2], y[3]);
                if (!dry) *(uint2*)zp = o;
            }
        }
    }
#pragma unroll
    for (int nt = 0; nt < 4; ++nt) { ssq[nt] += __shfl_xor(ssq[nt], 16); ssq[nt] += __shfl_xor(ssq[nt], 32); }
    __syncthreads();
    if (g == 0) {
#pragma unroll
        for (int nt = 0; nt < 4; ++nt) red[w * 64 + nt * 16 + fr] = ssq[nt];
    }
    __syncthreads();
    const float* NW = p.ssm_norm_w + layer * 384;
#pragma unroll
    for (int nt = 0; nt < 4; ++nt) {
        const int l = nt * 16 + fr;
        const float tot = red[l] + red[64 + l] + red[128 + l] + red[192 + l];
        const float rstd = rsqrtf(tot * (1.f / 384.f) + 1e-6f);
#pragma unroll 1
        for (int h = 0; h < 6; ++h) {
            bf16_t* zp = P + (size_t)(tok0 + l0 + l) * LDP + C_SZ + h * 64 + 16 * w + g * 4;
            const uint2 zv = *(const uint2*)zp; const float4 nw = *(const float4*)(NW + h * 64 + 16 * w + g * 4);
            uint2 o; o.x = pack2(lo2f(zv.x) * rstd * nw.x, hi2f(zv.x) * rstd * nw.y); o.y = pack2(lo2f(zv.y) * rstd * nw.z, hi2f(zv.y) * rstd * nw.w);
            if (!dry) *(uint2*)zp = o;
        }
    }
}

__device__ void delta_prep_unit(const Params& p, int layer, int u, unsigned char* smem, bool dry = false) {
    const int tid = opaque_tid(), lane = tid & 63, w = tid >> 6, fr = lane & 15, g = lane >> 4;
    const int h = u % 6; const int bc = u / 6; const int c = bc & 127; const int tok0 = bc * 64;
    bf16_t* P = (bf16_t*)(p.ws + WS_P);
    const bf16_t* halo = (const bf16_t*)(p.ws + WS_HALO);
    bf16_t* q16 = (bf16_t*)smem; bf16_t* k16 = q16 + 64 * 72;
    float* X = (float*)(smem + 18432);
    float* Lm = (float*)(smem + 51200);
    float* gcl = (float*)(smem + 67584); float* betal = gcl + 64;
    const float* SM = (const float*)(p.ws + WS_SM);
    const float* CW = p.dn_conv_w + (size_t)layer * 4 * 1152; const float* CB = p.dn_conv_b + (size_t)layer * 1152;
    __syncthreads();
    if (tid < 64) {
        const float bt = 1.f / (1.f + __expf(-SM[(size_t)(tok0 + tid) * 32 + 6 + h]));
        const float gv = -__expf(p.dn_A_log[layer * 6 + h]) * softplus_f(SM[(size_t)(tok0 + tid) * 32 + 12 + h] + p.dn_dt_bias[layer * 6 + h]);
        const float gc = wave_incl_scan(gv, lane);
        gcl[tid] = gc; betal[tid] = bt;
        ((float*)(p.ws + WS_GC))[(size_t)(tok0 + tid) * 8 + h] = gc;
    }
    __syncthreads();
    const int cgp = tid & 7;
#pragma unroll 1
    for (int mat = 0; mat < 3; ++mat) {
        ConvW cw; load_convw(cw, CW, CB, 1152, mat * 384 + h * 64 + cgp * 8);
        const int col = C_DQ + mat * 384 + h * 64 + cgp * 8;
#pragma unroll
        for (int i = 0; i < 2; ++i) {
            const int row = (tid >> 3) + 32 * i; float o[8];
#pragma unroll
            for (int e = 0; e < 8; ++e) o[e] = cw.b[e];
#pragma unroll
            for (int t = 0; t < 4; ++t) {
                const int rr = row - 3 + t;
                if (rr >= 0) conv_acc(cw, t, *(const uint4*)(P + (size_t)(tok0 + rr) * LDP + col), o);
                else if (c > 0) conv_acc(cw, t, *(const uint4*)(halo + (size_t)((bc - 1) * 3 + rr + 3) * 1152 + mat * 384 + h * 64 + cgp * 8), o);
            }
            float ss = 0.f;
#pragma unroll
            for (int e = 0; e < 8; ++e) { o[e] = silu_f(o[e]); ss += o[e] * o[e]; }
            ss += __shfl_xor(ss, 1); ss += __shfl_xor(ss, 2); ss += __shfl_xor(ss, 4);
            const float rinv = rsqrtf(ss + 1e-6f);
            if (mat == 0) {
#pragma unroll
                for (int e = 0; e < 8; ++e) o[e] *= rinv * 0.125f;
                *(uint4*)(q16 + row * 72 + cgp * 8) = pack8(o);
            } else if (mat == 1) {
                const float sc = betal[row] * __expf(gcl[row]);
#pragma unroll
                for (int e = 0; e < 8; ++e) { o[e] *= rinv; X[row * 128 + 64 + cgp * 8 + e] = o[e] * sc; }
                *(uint4*)(k16 + row * 72 + cgp * 8) = pack8(o);
            } else {
                const float bt = betal[row];
#pragma unroll
                for (int e = 0; e < 8; ++e) X[row * 128 + cgp * 8 + e] = o[e] * bt;
            }
        }
    }
    __syncthreads();
    {
        f32x4 acc[4];
#pragma unroll
        for (int nt = 0; nt < 4; ++nt) acc[nt] = (f32x4){0.f, 0.f, 0.f, 0.f};
#pragma unroll
        for (int ks = 0; ks < 2; ++ks) {
            const bf16x8 a = *(const bf16x8*)(k16 + (16 * w + fr) * 72 + ks * 32 + g * 8);
#pragma unroll
            for (int nt = 0; nt < 4; ++nt) { const bf16x8 bb = *(const bf16x8*)(k16 + (nt * 16 + fr) * 72 + ks * 32 + g * 8); acc[nt] = mfma16(a, bb, acc[nt]); }
        }
#pragma unroll
        for (int nt = 0; nt < 4; ++nt)
#pragma unroll
            for (int j = 0; j < 4; ++j) {
                const int i = 16 * w + g * 4 + j, jj = nt * 16 + fr;
                Lm[i * 64 + jj] = (jj < i) ? acc[nt][j] * betal[i] * __expf(gcl[i] - gcl[jj]) : 0.f;
            }
    }
    __syncthreads();
    if (tid < 128) {
        float xr[64];
#pragma unroll
        for (int i = 0; i < 64; ++i) xr[i] = X[i * 128 + tid];
#pragma unroll
        for (int i = 1; i < 64; ++i) {
            float a0 = 0.f, a1 = 0.f, a2 = 0.f, a3 = 0.f;
#pragma unroll
            for (int j = 0; j < i; ++j) {
                const float lv = Lm[i * 64 + j];
                if ((j & 3) == 0) a0 += lv * xr[j]; else if ((j & 3) == 1) a1 += lv * xr[j]; else if ((j & 3) == 2) a2 += lv * xr[j]; else a3 += lv * xr[j];
            }
            xr[i] -= (a0 + a1) + (a2 + a3);
        }
#pragma unroll
        for (int i = 1; i < 64; ++i) X[i * 128 + tid] = xr[i];
    }
    __syncthreads();
    bf16_t* WB = (bf16_t*)(p.ws + WS_WB);
    if (!dry)
#pragma unroll
    for (int i = 0; i < 2; ++i) {
        const int row = (tid >> 3) + 32 * i;
        bf16_t* pr = P + (size_t)(tok0 + row) * LDP + h * 64 + cgp * 8;
        *(uint4*)(pr + C_DQ) = *(const uint4*)(q16 + row * 72 + cgp * 8);
        *(uint4*)(pr + C_DK) = *(const uint4*)(k16 + row * 72 + cgp * 8);
        *(uint4*)(pr + C_DV) = pack8(X + row * 128 + cgp * 8);
        *(uint4*)(WB + (size_t)(tok0 + row) * 384 + h * 64 + cgp * 8) = pack8(X + row * 128 + 64 + cgp * 8);
    }
    bf16_t* kdT = (bf16_t*)Lm; bf16_t* uT = (bf16_t*)(smem + 68608);
    {
        const float gl = gcl[63];
#pragma unroll
        for (int i = 0; i < 2; ++i) {
            const int row = (tid >> 3) + 32 * i;
            float kf[8]; unpack8(*(const uint4*)(k16 + row * 72 + cgp * 8), kf);
            const float sc = __expf(gl - gcl[row]);
#pragma unroll
            for (int e = 0; e < 8; ++e) { kdT[(cgp * 8 + e) * 72 + row] = f2bf(kf[e] * sc); uT[(cgp * 8 + e) * 72 + row] = f2bf(X[row * 128 + cgp * 8 + e]); }
        }
    }
    __syncthreads();
    {
        f32x4 acc[4];
#pragma unroll
        for (int nt = 0; nt < 4; ++nt) acc[nt] = (f32x4){0.f, 0.f, 0.f, 0.f};
#pragma unroll
        for (int ks = 0; ks < 2; ++ks) {
            const bf16x8 a = *(const bf16x8*)(kdT + (16 * w + fr) * 72 + ks * 32 + g * 8);
#pragma unroll
            for (int nt = 0; nt < 4; ++nt) { const bf16x8 bb = *(const bf16x8*)(uT + (nt * 16 + fr) * 72 + ks * 32 + g * 8); acc[nt] = mfma16(a, bb, acc[nt]); }
        }
        bf16_t* QB = (bf16_t*)(p.ws + WS_QB) + ((size_t)bc * 6 + h) * 4096;
        if (!dry)
#pragma unroll
        for (int nt = 0; nt < 4; ++nt) { uint2 o; o.x = pack2(acc[nt][0], acc[nt][1]); o.y = pack2(acc[nt][2], acc[nt][3]); *(uint2*)(QB + (nt * 16 + fr) * 64 + 16 * w + g * 4) = o; }
    }
}

__device__ void delta_scan_unit(const Params& p, int layer, int u, unsigned char* smem, bool dry = false) {
    const int tid = opaque_tid(), lane = tid & 63, w = tid >> 6, fr = lane & 15, g = lane >> 4;
    const int b = u / 6, h = u % 6;
    const bf16_t* P = (const bf16_t*)(p.ws + WS_P);
    const bf16_t* WB = (const bf16_t*)(p.ws + WS_WB); const float* GC = (const float*)(p.ws + WS_GC);
    const bf16_t* QB = (const bf16_t*)(p.ws + WS_QB); bf16_t* SB = (bf16_t*)(p.ws + WS_SB);
    bf16_t* w16 = (bf16_t*)smem; bf16_t* kdT = w16 + 64 * 72; bf16_t* St = kdT + 64 * 72; bf16_t* wsT = St + 64 * 72;
    f32x4 S[4];
#pragma unroll
    for (int nt = 0; nt < 4; ++nt) S[nt] = (f32x4){0.f, 0.f, 0.f, 0.f};
    __syncthreads();
    for (int i = tid; i < 64 * 72 / 2; i += 256) ((unsigned*)St)[i] = 0u;
    const int cgp = tid & 7, row0 = tid >> 3;
    uint4 wv0, wv1, kv0, kv1; float gr0, gr1, gl; uint2 qr[4];
#define DS_PREFETCH(c_) do { const int tk_ = b * SEQ + (c_) * 64; \
        const bf16_t* pr_ = P + (size_t)(tk_ + row0) * LDP + C_DK + h * 64 + cgp * 8; \
        kv0 = *(const uint4*)pr_; kv1 = *(const uint4*)(pr_ + (size_t)32 * LDP); \
        const bf16_t* wr_ = WB + (size_t)(tk_ + row0) * 384 + h * 64 + cgp * 8; \
        wv0 = *(const uint4*)wr_; wv1 = *(const uint4*)(wr_ + 32 * 384); \
        gr0 = GC[(size_t)(tk_ + row0) * 8 + h]; gr1 = GC[(size_t)(tk_ + row0 + 32) * 8 + h]; gl = GC[(size_t)(tk_ + 63) * 8 + h]; \
        const bf16_t* qb_ = QB + ((size_t)(b * 128 + (c_)) * 6 + h) * 4096 + 16 * w + g * 4; \
        _Pragma("unroll") for (int nt = 0; nt < 4; ++nt) qr[nt] = *(const uint2*)(qb_ + (nt * 16 + fr) * 64); } while (0)
    DS_PREFETCH(0);
#pragma unroll 1
    for (int c = 0; c < 128; ++c) {
        __syncthreads();
        *(uint4*)(w16 + row0 * 72 + cgp * 8) = wv0; *(uint4*)(w16 + (row0 + 32) * 72 + cgp * 8) = wv1;
        {
            float kf[8]; unpack8(kv0, kf); float sc = __expf(gl - gr0);
            const int c0 = row0 ^ (cgp * 8), c1 = (row0 + 32) ^ (cgp * 8);
#pragma unroll
            for (int e = 0; e < 8; e += 2) { const unsigned pk = pack2(kf[e] * sc, kf[e + 1] * sc); kdT[(cgp * 8 + e) * 72 + c0] = (bf16_t)(pk & 0xffff); kdT[(cgp * 8 + e + 1) * 72 + c0] = (bf16_t)(pk >> 16); }
            unpack8(kv1, kf); sc = __expf(gl - gr1);
#pragma unroll
            for (int e = 0; e < 8; e += 2) { const unsigned pk = pack2(kf[e] * sc, kf[e + 1] * sc); kdT[(cgp * 8 + e) * 72 + c1] = (bf16_t)(pk & 0xffff); kdT[(cgp * 8 + e + 1) * 72 + c1] = (bf16_t)(pk >> 16); }
        }
        const float eg = __expf(gl);
        float qc[4][4];
#pragma unroll
        for (int nt = 0; nt < 4; ++nt) { qc[nt][0] = lo2f(qr[nt].x); qc[nt][1] = hi2f(qr[nt].x); qc[nt][2] = lo2f(qr[nt].y); qc[nt][3] = hi2f(qr[nt].y); }
        __syncthreads();
        if (c + 1 < 128) DS_PREFETCH(c + 1);
        __builtin_amdgcn_sched_barrier(0);
        if (!dry) {
            bf16_t* sb = SB + ((size_t)(b * 128 + c) * 6 + h) * 4096 + 16 * w + g * 4;
#pragma unroll
            for (int nt = 0; nt < 4; ++nt) { uint2 o; o.x = pack2(S[nt][0], S[nt][1]); o.y = pack2(S[nt][2], S[nt][3]); *(uint2*)(sb + (nt * 16 + fr) * 64) = o; }
        }
        __builtin_amdgcn_sched_barrier(0);
        {
            f32x4 acc[4];
#pragma unroll
            for (int nt = 0; nt < 4; ++nt) acc[nt] = (f32x4){0.f, 0.f, 0.f, 0.f};
#pragma unroll
            for (int ks = 0; ks < 2; ++ks) {
                const bf16x8 a = *(const bf16x8*)(w16 + (16 * w + fr) * 72 + ks * 32 + g * 8);
#pragma unroll
                for (int nt = 0; nt < 4; ++nt) { const bf16x8 bb = *(const bf16x8*)(St + (nt * 16 + fr) * 72 + ks * 32 + g * 8); acc[nt] = mfma16(a, bb, acc[nt]); }
            }
#pragma unroll
            for (int nt = 0; nt < 4; ++nt) { uint2 o; o.x = pack2(acc[nt][0], acc[nt][1]); o.y = pack2(acc[nt][2], acc[nt][3]); *(uint2*)(wsT + (nt * 16 + fr) * 72 + 16 * w + g * 4) = o; }
        }
        __syncthreads();
        {
            f32x4 acc[4];
#pragma unroll
            for (int nt = 0; nt < 4; ++nt) acc[nt] = (f32x4){0.f, 0.f, 0.f, 0.f};
#pragma unroll
            for (int ks = 0; ks < 2; ++ks) {
                const bf16x8 a = *(const bf16x8*)(kdT + (16 * w + fr) * 72 + ((ks * 32 + g * 8) ^ (((2 * w + (fr >> 3)) & 7) << 3)));
#pragma unroll
                for (int nt = 0; nt < 4; ++nt) { const bf16x8 bb = *(const bf16x8*)(wsT + (nt * 16 + fr) * 72 + ks * 32 + g * 8); acc[nt] = mfma16(a, bb, acc[nt]); }
            }
#pragma unroll
            for (int nt = 0; nt < 4; ++nt) {
#pragma unroll
                for (int j = 0; j < 4; ++j) S[nt][j] = S[nt][j] * eg + qc[nt][j] - acc[nt][j];
                uint2 o; o.x = pack2(S[nt][0], S[nt][1]); o.y = pack2(S[nt][2], S[nt][3]); *(uint2*)(St + (nt * 16 + fr) * 72 + 16 * w + g * 4) = o;
            }
        }
    }
#undef DS_PREFETCH
}

__device__ void delta_out_unit(const Params& p, int layer, int u, unsigned char* smem, bool dry = false) {
    const int tid = opaque_tid(), lane = tid & 63, w = tid >> 6, fr = lane & 15, g = lane >> 4;
    const int h = u % 6; const int bc = u / 6; const int tok0 = bc * 64;
    bf16_t* P = (bf16_t*)(p.ws + WS_P);
    const bf16_t* WB = (const bf16_t*)(p.ws + WS_WB); const float* GC = (const float*)(p.ws + WS_GC);
    const bf16_t* SB = (const bf16_t*)(p.ws + WS_SB) + ((size_t)bc * 6 + h) * 4096;
    bf16_t* q16 = (bf16_t*)smem; bf16_t* k16 = q16 + 64 * 72; bf16_t* w16 = k16 + 64 * 72; bf16_t* St = w16 + 64 * 72;
    bf16_t* att = St + 64 * 72; bf16_t* vnT = att + 64 * 72; bf16_t* u16 = vnT + 64 * 72;
    float* gcl = (float*)(smem + 64512);
    const int cgp = tid & 7;
    __syncthreads();
#pragma unroll
    for (int i = 0; i < 2; ++i) {
        const int row = (tid >> 3) + 32 * i;
        const bf16_t* pr = P + (size_t)(tok0 + row) * LDP + h * 64 + cgp * 8;
        *(uint4*)(q16 + row * 72 + cgp * 8) = *(const uint4*)(pr + C_DQ);
        *(uint4*)(k16 + row * 72 + cgp * 8) = *(const uint4*)(pr + C_DK);
        *(uint4*)(u16 + row * 72 + cgp * 8) = *(const uint4*)(pr + C_DV);
        *(uint4*)(w16 + row * 72 + cgp * 8) = *(const uint4*)(WB + (size_t)(tok0 + row) * 384 + h * 64 + cgp * 8);
        *(uint4*)(St + row * 72 + cgp * 8) = *(const uint4*)(SB + row * 64 + cgp * 8);
        if (cgp == 0) gcl[row] = GC[(size_t)(tok0 + row) * 8 + h];
    }
    float gt[4][4];
#pragma unroll
    for (int nt = 0; nt < 4; ++nt)
#pragma unroll
        for (int j = 0; j < 4; ++j) gt[nt][j] = bf2f(P[(size_t)(tok0 + 16 * w + g * 4 + j) * LDP + C_DG + h * 64 + nt * 16 + fr]);
    __syncthreads();
    {
        f32x4 acc[4];
#pragma unroll
        for (int nt = 0; nt < 4; ++nt) acc[nt] = (f32x4){0.f, 0.f, 0.f, 0.f};
#pragma unroll
        for (int ks = 0; ks < 2; ++ks) {
            const bf16x8 a = *(const bf16x8*)(k16 + (16 * w + fr) * 72 + ks * 32 + g * 8);
#pragma unroll
            for (int nt = 0; nt < 4; ++nt) { const bf16x8 bb = *(const bf16x8*)(q16 + (nt * 16 + fr) * 72 + ks * 32 + g * 8); acc[nt] = mfma16(a, bb, acc[nt]); }
        }
#pragma unroll
        for (int nt = 0; nt < 4; ++nt) {
            const int i = nt * 16 + fr; const float gi = gcl[i]; float v[4];
#pragma unroll
            for (int jj = 0; jj < 4; ++jj) { const int j = 16 * w + g * 4 + jj; v[jj] = (j <= i) ? acc[nt][jj] * __expf(gi - gcl[j]) : 0.f; }
            uint2 o; o.x = pack2(v[0], v[1]); o.y = pack2(v[2], v[3]);
            *(uint2*)(att + i * 72 + 16 * w + g * 4) = o;
        }
    }
    {
        f32x4 acc[4];
#pragma unroll
        for (int nt = 0; nt < 4; ++nt) acc[nt] = (f32x4){0.f, 0.f, 0.f, 0.f};
#pragma unroll
        for (int ks = 0; ks < 2; ++ks) {
            const bf16x8 a = *(const bf16x8*)(w16 + (16 * w + fr) * 72 + ks * 32 + g * 8);
#pragma unroll
            for (int nt = 0; nt < 4; ++nt) { const bf16x8 bb = *(const bf16x8*)(St + (nt * 16 + fr) * 72 + ks * 32 + g * 8); acc[nt] = mfma16(a, bb, acc[nt]); }
        }
#pragma unroll
        for (int nt = 0; nt < 4; ++nt) {
            float v[4];
#pragma unroll
            for (int j = 0; j < 4; ++j) v[j] = bf2f(u16[(16 * w + g * 4 + j) * 72 + nt * 16 + fr]) - acc[nt][j];
            uint2 o; o.x = pack2(v[0], v[1]); o.y = pack2(v[2], v[3]);
            *(uint2*)(vnT + (nt * 16 + fr) * 72 + 16 * w + g * 4) = o;
        }
    }
    __syncthreads();
    f32x4 oa[4], ob[4];
#pragma unroll
    for (int nt = 0; nt < 4; ++nt) { oa[nt] = (f32x4){0.f, 0.f, 0.f, 0.f}; ob[nt] = (f32x4){0.f, 0.f, 0.f, 0.f}; }
#pragma unroll
    for (int ks = 0; ks < 2; ++ks) {
        const bf16x8 a = *(const bf16x8*)(q16 + (16 * w + fr) * 72 + ks * 32 + g * 8);
        const bf16x8 a2 = *(const bf16x8*)(att + (16 * w + fr) * 72 + ks * 32 + g * 8);
#pragma unroll
        for (int nt = 0; nt < 4; ++nt) {
            const bf16x8 bb = *(const bf16x8*)(St + (nt * 16 + fr) * 72 + ks * 32 + g * 8); oa[nt] = mfma16(a, bb, oa[nt]);
            const bf16x8 b2 = *(const bf16x8*)(vnT + (nt * 16 + fr) * 72 + ks * 32 + g * 8); ob[nt] = mfma16(a2, b2, ob[nt]);
        }
    }
    float eg4[4], ss[4];
#pragma unroll
    for (int j = 0; j < 4; ++j) { eg4[j] = __expf(gcl[16 * w + g * 4 + j]); ss[j] = 0.f; }
    float ov[4][4];
#pragma unroll
    for (int nt = 0; nt < 4; ++nt)
#pragma unroll
        for (int j = 0; j < 4; ++j) { ov[nt][j] = oa[nt][j] * eg4[j] + ob[nt][j]; ss[j] += ov[nt][j] * ov[nt][j]; }
#pragma unroll
    for (int j = 0; j < 4; ++j) { ss[j] += __shfl_xor(ss[j], 1); ss[j] += __shfl_xor(ss[j], 2); ss[j] += __shfl_xor(ss[j], 4); ss[j] += __shfl_xor(ss[j], 8); ss[j] = rsqrtf(ss[j] * (1.f / 64.f) + 1e-6f); }
    if (!dry)
#pragma unroll
    for (int nt = 0; nt < 4; ++nt) {
        const float nw = p.dn_norm_w[layer * 64 + nt * 16 + fr];
#pragma unroll
        for (int j = 0; j < 4; ++j)
            P[(size_t)(tok0 + 16 * w + g * 4 + j) * LDP + C_DG + h * 64 + nt * 16 + fr] = f2bf(ov[nt][j] * ss[j] * nw * silu_f(gt[nt][j]));
    }
}

__global__ void __launch_bounds__(256, 2) mega_kernel(Params p) {
    extern __shared__ __attribute__((aligned(16))) unsigned char smem[];
    __shared__ int s_unit;
    cg::grid_group grid = cg::this_grid();
    unsigned* ctr = (unsigned*)(p.ws + WS_CTR);
    unsigned nbar = 0;
    __shared__ unsigned xb_st[2];
    if (threadIdx.x < 2) xb_st[threadIdx.x] = 0u;
    __syncthreads();
    const XcdBarrier xb = xcd_barrier_post((unsigned*)(p.ws + WS_XBAR), (volatile LAS unsigned*)xb_st);
    __shared__ int s_cu[2];
    unsigned* cutab = (unsigned*)(p.ws + WS_CUTAB);
    if (threadIdx.x == 0) {
        const unsigned xcc = __builtin_amdgcn_s_getreg((3 << 11) | 20) & 15u;
        const unsigned hw = __builtin_amdgcn_s_getreg((7 << 11) | (8 << 6) | 4) & 255u;
        const unsigned slot = (xcc << 8) | hw;
        const unsigned idx = __hip_atomic_fetch_add(&cutab[slot], 1u, __ATOMIC_RELAXED, __HIP_MEMORY_SCOPE_AGENT);
        if (idx == 0u) { const unsigned r = __hip_atomic_fetch_add(&cutab[8192], 1u, __ATOMIC_RELAXED, __HIP_MEMORY_SCOPE_AGENT); __hip_atomic_store(&cutab[4096 + slot], r + 1u, __ATOMIC_RELAXED, __HIP_MEMORY_SCOPE_AGENT); }
        s_cu[0] = (idx == 0u) ? 1 : 0; s_cu[1] = (int)slot;
    }
    __syncthreads();
    for (int ph = p.ph_lo; ph < p.ph_hi; ++ph) {
        if (ph == 0) {
            for (;;) { const int u = next_unit(ctr + ph, &s_unit); if (u >= 384 + 128 + 512) break; if (u < 384) conv_win_unit(p, 0, u); else if (u < 512) conv_wout_unit(p, u - 384); else conv_x_unit(p, u - 512); }
#if PROBE == 10 || PROBE == 11
            {
                const bf16_t* Pp = (const bf16_t*)(p.ws + WS_P); unsigned acc = 0; const int tid_ = threadIdx.x; const int cg_ = tid_ & 7, r0_ = tid_ >> 3;
                for (int it = 0; it < 400; ++it) {
                    const int T = (int)((blockIdx.x * 131u + (unsigned)it * 1777u) % (128u * 92u));
                    const int rb = T % 128, cb = T / 128;
#pragma unroll
                    for (int i = 0; i < 4; ++i) {
                        const int row = r0_ + 32 * i;
                        const size_t ad = (PROBE == 10) ? ((size_t)(rb * 128 + row) * LDP + cb * 64 + cg_ * 8) : ((size_t)T * 8192 + row * 64 + cg_ * 8);
                        const uint4 v = *(const uint4*)(Pp + ad); acc += v.x ^ v.y ^ v.z ^ v.w;
                    }
                    __syncthreads();
                }
                if (acc == 0x12345u) ((unsigned*)(p.ws + WS_CTR))[255] = acc;
            }
#endif
        } else {
            const int layer = (ph - 1) / 6, sub = (ph - 1) % 6;
            if (sub == 0) {
                const int xcd0 = (int)(__builtin_amdgcn_s_getreg((3 << 11) | 20) & 7u);
                for (int rep = 0; rep < ((PROBE == 1 || PROBE == 15) ? 2 : 1); ++rep)
                for (int sx = 0; sx < 8; ++sx) {
                    const int x = (xcd0 + sx) & 7;
                    unsigned* cq = ctr + 64 + rep * 64 + (layer * 2) * 8 + x;
                    int q = next_unit(cq, &s_unit);
                    while (q < 752) {
                        unsigned nxq = 0u; if (threadIdx.x == 0) nxq = __hip_atomic_fetch_add(cq, 1u, __ATOMIC_RELAXED, __HIP_MEMORY_SCOPE_AGENT);
                        const int tmg = q / 376, r = q % 376; const int tng = r >> 6, rr = r & 63;
                        gemm_unit<0>(p, layer, x * 16 + tmg * 8 + (rr & 7), tng * 8 + (rr >> 3), smem, PROBE == 15 && rep == 0);
                        __syncthreads(); if (threadIdx.x == 0) s_unit = (int)nxq; __syncthreads(); q = s_unit;
                    }
                }
            } else if (sub == 1) {
                const int n0 = 64, n1 = n0 + 256, n2 = n1 + 1536, n3 = n2 + 1536;
                for (int rep = (PROBE == 4 ? 0 : 1); rep < 2; ++rep) {
                if (rep == 1 && PROBE == 4) { ++nbar; grid_barrier(ctr + 48, nbar * gridDim.x); }
                for (;;) {
                    const bool dry = rep == 0;
                    const int u = next_unit(ctr + ph + (dry ? 16 : 0), &s_unit); if (u >= n3) break;
                    if (u < n0) kmean_unit(p, u, smem);
                    else if (u < n1) ssd_states_unit(p, layer, u - n0, smem);
                    else if (u < n2) delta_prep_unit(p, layer, u - n1, smem, dry);
                    else dil_unit(p, 0, u - n2, smem, dry);
                }
                }
            } else if (sub == 2) {
                const int xcd0 = (int)(__builtin_amdgcn_s_getreg((3 << 11) | 20) & 7u);
                const unsigned nprim = __hip_atomic_load(&cutab[8192], __ATOMIC_RELAXED, __HIP_MEMORY_SCOPE_AGENT);
                const int curank = (int)__hip_atomic_load(&cutab[4096 + s_cu[1]], __ATOMIC_RELAXED, __HIP_MEMORY_SCOPE_AGENT) - 1;
                const bool excl = nprim >= 12u;
                if (excl && curank >= 0 && curank < 12) {
                    if (s_cu[0]) delta_scan_unit(p, layer, curank, smem, false);
                } else {
                    for (;;) { const int u = next_unit(ctr + ph, &s_unit); if (u >= 60) break; if (u < 12) { if (!excl) delta_scan_unit(p, layer, u, smem, false); } else ssd_scan_unit(p, u - 12); }
                    for (int sx = 0; sx < 8; ++sx) {
                        const int x = (xcd0 + sx) & 7;
                        for (;;) { const int q = next_unit(ctr + 200 + layer * 8 + x, &s_unit); if (q >= 96) break; moba_unit(p, x, q, smem, false); }
                    }
                    for (;;) { const int u = next_unit(ctr + 240 + layer, &s_unit); if (u >= 1536) break; dil_unit(p, 1, u, smem, false); }
                }
            } else if (sub == 3) {
                const int n0 = 256, n1 = n0 + 1536, n2 = n1 + 1536;
                for (int rep = (PROBE == 5 ? 0 : 1); rep < 2; ++rep) {
                if (rep == 1 && PROBE == 5) { ++nbar; grid_barrier(ctr + 48, nbar * gridDim.x); }
                for (;;) {
                    const bool dry = rep == 0;
                    const int u = next_unit(ctr + ph + (dry ? 16 : 0), &s_unit); if (u >= n2) break;
                    if (u < n0) ssd_out_unit(p, layer, u, smem, dry); else if (u < n1) dil_unit(p, 2, u - n0, smem, dry); else delta_out_unit(p, layer, u - n1, smem, dry);
                }
                }
            } else if (sub == 4) {
                if (layer == 0) { for (;;) { const int u = next_unit(ctr + ph, &s_unit); if (u >= 384) break; conv_win_unit(p, 1, u); } }
                const int xcd0 = (int)(__builtin_amdgcn_s_getreg((3 << 11) | 20) & 7u);
                for (int sx = 0; sx < 8; ++sx) {
                    const int x = (xcd0 + sx) & 7;
                    unsigned* cq = ctr + 64 + (layer * 2 + 1) * 8 + x;
                    int q = next_unit(cq, &s_unit);
                    while (q < 128) {
                        unsigned nxq = 0u; if (threadIdx.x == 0) nxq = __hip_atomic_fetch_add(cq, 1u, __ATOMIC_RELAXED, __HIP_MEMORY_SCOPE_AGENT);
                        const int tmg = q >> 6, rr = q & 63;
                        gemm_unit<1>(p, layer, x * 16 + tmg * 8 + (rr & 7), rr >> 3, smem);
                        __syncthreads(); if (threadIdx.x == 0) s_unit = (int)nxq; __syncthreads(); q = s_unit;
                    }
                }
            } else {
                for (;;) { const int u = next_unit(ctr + ph, &s_unit); if (u >= 512) break; ln_unit(p, layer, u); }
            }
        }
        if (ph + 1 < p.ph_hi) {
            if (p.ph_lo < 0) grid.sync();
            xcd_barrier(xb);
        }
    }
}

extern "C" void kernel_launch(void* const* d_in, const int* in_sizes, int n_in, void* d_out, int out_size, void* d_ws, size_t ws_size, hipStream_t stream) {
    static int grid_blocks = 0;
    if (!grid_blocks) {
        if (n_in != 16 || ws_size < WS_END) { fprintf(stderr, "kernel_launch: bad args n_in=%d ws=%zu need %zu\n", n_in, ws_size, (size_t)WS_END); grid_blocks = -1; return; }
        int dev = 0, cus = 0, per_cu = 0;
        hipGetDevice(&dev);
        hipDeviceGetAttribute(&cus, hipDeviceAttributeMultiprocessorCount, dev);
        if (hipFuncSetAttribute((const void*)mega_kernel, hipFuncAttributeMaxDynamicSharedMemorySize, LDS_BYTES) != hipSuccess) fprintf(stderr, "hipFuncSetAttribute failed\n");
        if (hipOccupancyMaxActiveBlocksPerMultiprocessor(&per_cu, (const void*)mega_kernel, 256, LDS_BYTES) != hipSuccess || per_cu < 1) { fprintf(stderr, "occupancy query failed/0: %d\n", per_cu); per_cu = 1; }
        (void)hipGetLastError();
        if (per_cu > 2) per_cu = 2;
        grid_blocks = cus * per_cu;
        fprintf(stderr, "kernel_launch: cus=%d per_cu=%d grid=%d ws_need=%zu ws=%zu\n", cus, per_cu, grid_blocks, (size_t)WS_END, ws_size);
    }
    if (grid_blocks < 0) return;
    (void)hipMemsetAsync((char*)d_ws + WS_XBAR, 0, WS_END - WS_XBAR, stream);
    Params p{};
    p.x = (const float*)d_in[0]; p.w_in = (const float*)d_in[1]; p.w_out = (const float*)d_in[2];
    p.ssm_conv_w = (const float*)d_in[3]; p.ssm_conv_b = (const float*)d_in[4]; p.ssm_dt_bias = (const float*)d_in[5]; p.ssm_A_log = (const float*)d_in[6];
    p.ssm_D = (const float*)d_in[7]; p.ssm_norm_w = (const float*)d_in[8];
    p.dn_conv_w = (const float*)d_in[9]; p.dn_conv_b = (const float*)d_in[10]; p.dn_dt_bias = (const float*)d_in[11]; p.dn_A_log = (const float*)d_in[12]; p.dn_norm_w = (const float*)d_in[13];
    p.ln_g = (const float*)d_in[14]; p.ln_b = (const float*)d_in[15];
    p.out = (float*)d_out; p.ws = (unsigned char*)d_ws; p.ph_lo = 0; p.ph_hi = 13;
    void* args[] = {&p};
    hipError_t e = hipLaunchCooperativeKernel((const void*)mega_kernel, dim3(grid_blocks), dim3(256), args, LDS_BYTES, stream);
    if (e != hipSuccess) fprintf(stderr, "cooperative launch failed: %s (grid %d)\n", hipGetErrorString(e), grid_blocks);
}
#ifdef PROBE_UNITS
#define PK(name, call) __global__ void __launch_bounds__(256, 2) name(Params p, int u) { extern __shared__ __attribute__((aligned(16))) unsigned char smem[]; call; }
PK(k_convwin, conv_win_unit(p, 0, u))
PK(k_convwout, conv_wout_unit(p, u))
PK(k_gemm0, gemm_unit<0>(p, 0, u, u, smem))
PK(k_gemm1, gemm_unit<1>(p, 0, u, u, smem))
PK(k_ln, ln_unit(p, 0, u))
PK(k_kmean, kmean_unit(p, u, smem))
PK(k_moba, moba_unit(p, u & 7, u, smem))
PK(k_dil, dil_unit(p, p.ph_lo, u, smem))
PK(k_ssdst, ssd_states_unit(p, 0, u, smem))
PK(k_ssdscan, ssd_scan_unit(p, u))
PK(k_ssdout, ssd_out_unit(p, 0, u, smem))
PK(k_dprep, delta_prep_unit(p, 0, u, smem))
PK(k_dscan, delta_scan_unit(p, 0, u, smem))
PK(k_dout, delta_out_unit(p, 0, u, smem))
#endif
```

```cpp
#include <hip/hip_runtime.h>
#include <hip/hip_cooperative_groups.h>
#include <cstdio>
#include <cstdint>
namespace cg = cooperative_groups;

typedef unsigned short bf16_t;
typedef short bf16x8 __attribute__((ext_vector_type(8)));
typedef short bf16x4 __attribute__((ext_vector_type(4)));
typedef float f32x4 __attribute__((ext_vector_type(4)));

constexpr int NTOK = 16384, SEQ = 8192, DM = 1024, LDP = 5888, INC = 5906, DMIX = 1536;
constexpr int NWIN = 6144;
constexpr int C_AQ = 0, C_AK = 384, C_AV = 768, C_AG = 1152, C_SX = 1536, C_SB = 1920, C_SC = 2176, C_SZ = 2432;
constexpr int C_CQ = 2816, C_CK = 3200, C_CV = 3584, C_CG = 3968, C_DQ = 4352, C_DK = 4736, C_DV = 5120, C_DG = 5504;
constexpr float DN_ALPHA = 1.4142135623730951f;

constexpr size_t WS_P = 0;
constexpr size_t WS_SM = WS_P + (size_t)NTOK * LDP * 2;
constexpr size_t WS_WINT = WS_SM + (size_t)NTOK * 32 * 4;
constexpr size_t WS_WOUTT = WS_WINT + (size_t)NWIN * 1024 * 2;
constexpr size_t WS_HALO = WS_WOUTT + (size_t)2 * 1024 * 1536 * 2;
constexpr size_t WS_WB = WS_HALO + (size_t)256 * 3 * 1152 * 2;
constexpr size_t WS_GC = WS_WB + (size_t)NTOK * 384 * 2;
constexpr size_t WS_DILO = WS_GC + (size_t)NTOK * 8 * 4;
constexpr size_t WS_DILL = WS_DILO + (size_t)NTOK * 384 * 2;
constexpr size_t WS_ST = WS_DILL + (size_t)NTOK * 8 * 4;
constexpr size_t WS_CDEC = WS_ST + (size_t)2 * 64 * 6 * 8192 * 2;
constexpr size_t WS_KMEAN = WS_CDEC + 4096;
constexpr size_t WS_QB = WS_KMEAN + (size_t)2 * 6 * 32 * 64 * 4;
constexpr size_t WS_XBAR = WS_QB + (size_t)256 * 6 * 4096 * 2;
constexpr size_t WS_CUTAB = WS_XBAR + 16384;
constexpr size_t WS_CTR = WS_CUTAB + 2 * 16384 + 64;
constexpr size_t WS_END = WS_CTR + 1024;
constexpr size_t WS_SB = WS_WINT;
static_assert((size_t)256 * 6 * 4096 * 2 <= (size_t)NWIN * 1024 * 2, "SB alias overflow");
constexpr size_t WS_XB = WS_WB;
static_assert(WS_XB + (size_t)NTOK * 1024 * 2 <= WS_CDEC, "XB alias overflow");

constexpr int LDS_BYTES = 79 * 1024;
#ifndef PROBE
#define PROBE 0
#endif

struct Params {
    const float* x; const float* w_in; const float* w_out;
    const float* ssm_conv_w; const float* ssm_conv_b; const float* ssm_dt_bias; const float* ssm_A_log; const float* ssm_D; const float* ssm_norm_w;
    const float* dn_conv_w; const float* dn_conv_b; const float* dn_dt_bias; const float* dn_A_log; const float* dn_norm_w;
    const float* ln_g; const float* ln_b;
    float* out; unsigned char* ws;
    int ph_lo, ph_hi;
};

__device__ __forceinline__ bf16_t f2bf(float f) { unsigned u = __float_as_uint(f); u += 0x7fffu + ((u >> 16) & 1u); return (bf16_t)(u >> 16); }
__device__ __forceinline__ float bf2f(bf16_t h) { return __uint_as_float(((unsigned)h) << 16); }
typedef float f32x2_t __attribute__((ext_vector_type(2)));
typedef __bf16 bf16x2_t __attribute__((ext_vector_type(2)));
__device__ __forceinline__ unsigned pack2(float a, float b) { f32x2_t v = {a, b}; bf16x2_t r = __builtin_convertvector(v, bf16x2_t); return __builtin_bit_cast(unsigned, r); }
__device__ __forceinline__ float lo2f(unsigned u) { return __uint_as_float(u << 16); }
__device__ __forceinline__ float hi2f(unsigned u) { return __uint_as_float(u & 0xffff0000u); }
__device__ __forceinline__ float silu_f(float x) { return x / (1.f + __expf(-x)); }
__device__ __forceinline__ float softplus_f(float x) { return x > 20.f ? x : log1pf(__expf(x)); }
__device__ __forceinline__ f32x4 mfma16(bf16x8 a, bf16x8 b, f32x4 c) { return __builtin_amdgcn_mfma_f32_16x16x32_bf16(a, b, c, 0, 0, 0); }
__device__ __forceinline__ void unpack8(uint4 v, float* f) {
    f[0] = lo2f(v.x); f[1] = hi2f(v.x); f[2] = lo2f(v.y); f[3] = hi2f(v.y); f[4] = lo2f(v.z); f[5] = hi2f(v.z); f[6] = lo2f(v.w); f[7] = hi2f(v.w);
}
__device__ __forceinline__ uint4 pack8(const float* f) { uint4 v; v.x = pack2(f[0], f[1]); v.y = pack2(f[2], f[3]); v.z = pack2(f[4], f[5]); v.w = pack2(f[6], f[7]); return v; }
__device__ __forceinline__ float wave_incl_scan(float x, int lane) {
#pragma unroll
    for (int o = 1; o < 64; o <<= 1) { float y = __shfl_up(x, o); if (lane >= o) x += y; }
    return x;
}

__device__ __forceinline__ int opaque_tid() { int t = threadIdx.x; asm volatile("" : "+v"(t)); return t; }
__device__ __forceinline__ void grid_barrier(unsigned* bar, unsigned target) {
    asm volatile("s_waitcnt vmcnt(0)" ::: "memory");
    __syncthreads();
    if (threadIdx.x == 0) {
        __builtin_amdgcn_fence(__ATOMIC_RELEASE, "agent");
        asm volatile("s_waitcnt vmcnt(0)" ::: "memory");
        __hip_atomic_fetch_add(bar, 1u, __ATOMIC_RELAXED, __HIP_MEMORY_SCOPE_AGENT);
        while (__hip_atomic_load(bar, __ATOMIC_RELAXED, __HIP_MEMORY_SCOPE_AGENT) < target) __builtin_amdgcn_s_sleep(2);
        __builtin_amdgcn_fence(__ATOMIC_ACQUIRE, "agent");
        asm volatile("s_waitcnt vmcnt(0)" ::: "memory");
    }
    __syncthreads();
}
#define XB_TMO      128
#define XB_XCNT(j)  (256  + 64 * (j))
#define XB_XSUB(j)  (1280 + 64 * (j))
#define XB_XGEN(j)  (2304 + 64 * (j))
#define XB_TOP      3328
#define XB_TOPGEN   3392
#define XCD_BAR_WORDS 3456
#define XB_SPIN_CAP (1u << 18)
#define LAS __attribute__((address_space(3)))

__device__ __forceinline__ unsigned xb_ld(unsigned* p)              { return __hip_atomic_load(p, __ATOMIC_RELAXED, __HIP_MEMORY_SCOPE_AGENT); }
__device__ __forceinline__ unsigned xb_add(unsigned* p, unsigned v) { return __hip_atomic_fetch_add(p, v, __ATOMIC_RELAXED, __HIP_MEMORY_SCOPE_AGENT); }
__device__ __forceinline__ unsigned xb_xcc_id() { return (unsigned)__builtin_amdgcn_s_getreg((3 << 11) | 20) & 0xFu; }
#define XB_SPIN(cond, bar) do { unsigned _sp = 0; while (cond) { __builtin_amdgcn_s_sleep(1); \
    if ((++_sp & 255u) == 0u) { if (xb_ld(&(bar)[XB_TMO])) break; if (_sp > XB_SPIN_CAP) { atomicAdd(&(bar)[XB_TMO], 1u); break; } } } } while (0)

struct XcdBarrier {
    unsigned* bar; unsigned x;
    volatile LAS unsigned* st;
};

__device__ __forceinline__ XcdBarrier xcd_barrier_post(unsigned* bar, volatile LAS unsigned* st) {
    XcdBarrier b; b.bar = bar; b.x = xb_xcc_id(); b.st = st;
    if (threadIdx.x == 0) (void)xb_add(&bar[XB_XCNT(b.x)], 1u);
    return b;
}
__device__ __forceinline__ void xcd_barrier_complete(unsigned* bar, unsigned x, unsigned& nloc, unsigned& nx) {
    const unsigned G = gridDim.x * gridDim.y * gridDim.z;
    unsigned sum, cnt, mine, sp = 0u;
    for (;;) {
        sum = 0u; cnt = 0u; mine = 0u;
#pragma unroll
        for (unsigned j = 0; j < 16; ++j) { const unsigned c = xb_ld(&bar[XB_XCNT(j)]); sum += c; cnt += (c > 0u) ? 1u : 0u; mine = (j == x) ? c : mine; }
        if (sum == G) break;
        __builtin_amdgcn_s_sleep(1);
        if ((++sp & 255u) == 0u) { if (xb_ld(&bar[XB_TMO])) break; if (sp > XB_SPIN_CAP) { atomicAdd(&bar[XB_TMO], 1u); break; } }
    }
    nloc = mine > 0u ? mine : 1u; nx = cnt > 0u ? cnt : 1u;
}

__device__ __forceinline__ void xcd_barrier(const XcdBarrier& b) {
    asm volatile("s_waitcnt vmcnt(0)" ::: "memory");
    __syncthreads();
    if (threadIdx.x == 0) {
        unsigned* bar = b.bar;
        __builtin_amdgcn_s_waitcnt(0);
        unsigned nloc = b.st[0], nx = b.st[1];
        if (nloc == 0u) { xcd_barrier_complete(bar, b.x, nloc, nx); b.st[0] = nloc; b.st[1] = nx; }
        const unsigned old = xb_add(&bar[XB_XSUB(b.x)], 1u);
        const unsigned gen = old / nloc;
        if (old + 1u == (gen + 1u) * nloc) {
            __builtin_amdgcn_fence(__ATOMIC_RELEASE, "agent");
            asm volatile("s_waitcnt vmcnt(0)" ::: "memory");
            const unsigned og = xb_add(&bar[XB_TOP], 1u);
            const unsigned tg = og / nx;
            if (og + 1u == (tg + 1u) * nx) xb_add(&bar[XB_TOPGEN], 1u);
            else XB_SPIN(xb_ld(&bar[XB_TOPGEN]) == tg, bar);
            __builtin_amdgcn_fence(__ATOMIC_ACQUIRE, "agent");
            xb_add(&bar[XB_XGEN(b.x)], 1u);
            asm volatile("s_waitcnt vmcnt(0)" ::: "memory");
        } else {
            XB_SPIN(xb_ld(&bar[XB_XGEN(b.x)]) == gen, bar);
            __builtin_amdgcn_fence(__ATOMIC_ACQUIRE, "agent");
            asm volatile("s_waitcnt vmcnt(0)" ::: "memory");
        }
    }
    __syncthreads();
}

__device__ __forceinline__ int next_unit(unsigned* ctr, int* s_unit) {
    __syncthreads();
    if (threadIdx.x == 0) *s_unit = (int)atomicAdd(ctr, 1u);
    __syncthreads();
    return *s_unit;
}

struct ConvW { float w[4][8]; float b[8]; };
__device__ __forceinline__ void load_convw(ConvW& cw, const float* W, const float* B, int C, int ch0) {
#pragma unroll
    for (int i = 0; i < 4; ++i)
#pragma unroll
        for (int e = 0; e < 8; ++e) cw.w[i][e] = W[i * C + ch0 + e];
#pragma unroll
    for (int e = 0; e < 8; ++e) cw.b[e] = B[ch0 + e];
}
__device__ __forceinline__ void conv_acc(const ConvW& cw, int tap, uint4 raw, float* acc) {
    float f[8]; unpack8(raw, f);
#pragma unroll
    for (int e = 0; e < 8; ++e) acc[e] += cw.w[tap][e] * f[e];
}

__device__ __forceinline__ int win_src_col(int n) {
    if (n < 2816) return n;
    if (n < 5888) return n + 6;
    if (n < 5894) return 2816 + (n - 5888);
    if (n < 5906) return n;
    return -1;
}
__device__ void conv_win_unit(const Params& p, int layer, int u4) {
    const int tid = opaque_tid(), nl = tid & 63, kq = tid >> 6;
    const int u = u4 >> 2, part = u4 & 3;
    const int n = u * 64 + nl; const int src = win_src_col(n);
    const float* W = p.w_in + (size_t)layer * 1024 * INC;
    bf16_t* dst = (bf16_t*)(p.ws + WS_WINT) + (size_t)n * 1024;
#pragma unroll 2
    for (int k0 = part * 256 + kq * 64; k0 < part * 256 + kq * 64 + 64; k0 += 8) {
        float f[8];
#pragma unroll
        for (int e = 0; e < 8; ++e) f[e] = src >= 0 ? W[(size_t)(k0 + e) * INC + src] : 0.f;
        *(uint4*)(dst + k0) = pack8(f);
    }
}
__device__ void conv_wout_unit(const Params& p, int u4) {
    const int tid = opaque_tid(), nl = tid & 63, kq = tid >> 6;
    const int u = u4 >> 2, part = u4 & 3;
    const int layer = u >> 4; const int n = (u & 15) * 64 + nl;
    const float* W = p.w_out + (size_t)layer * DMIX * 1024;
    bf16_t* dst = (bf16_t*)(p.ws + WS_WOUTT) + (size_t)layer * 1024 * DMIX + (size_t)n * DMIX;
#pragma unroll 2
    for (int k0 = part * 384 + kq * 96; k0 < part * 384 + kq * 96 + 96; k0 += 8) {
        float f[8];
#pragma unroll
        for (int e = 0; e < 8; ++e) f[e] = W[(size_t)(k0 + e) * 1024 + n];
        *(uint4*)(dst + k0) = pack8(f);
    }
}

template <int MODE>
__device__ void gemm_unit(const Params& p, int layer, int tm, int tn, unsigned char* smem, bool nostore = false) {
    const int tid = opaque_tid(), lane = tid & 63, w = tid >> 6, wr = w >> 1, wc = w & 1, fr = lane & 15, g = lane >> 4;
    constexpr int K = MODE == 0 ? 1024 : 1536;
    constexpr int NK = K / 64;
    bf16_t* As = (bf16_t*)smem;
    bf16_t* Bs = As + 2 * 128 * 72;
    const bf16_t* Bt = MODE == 0 ? (const bf16_t*)(p.ws + WS_WINT) : (const bf16_t*)(p.ws + WS_WOUTT) + (size_t)layer * 1024 * DMIX;
    const bf16_t* P = MODE == 0 ? (const bf16_t*)(p.ws + WS_XB) : (const bf16_t*)(p.ws + WS_P);
    constexpr int LDA = MODE == 0 ? 1024 : LDP;

    f32x4 acc[4][4];
#pragma unroll
    for (int i = 0; i < 4; ++i)
#pragma unroll
        for (int j = 0; j < 4; ++j) acc[i][j] = (f32x4){0.f, 0.f, 0.f, 0.f};

    uint4 rab0, rab1, rab2, rab3, rb0, rb1, rb2, rb3;
    const bool vt = (MODE == 0) && (tn >= 6) && (tn <= 8);
    const int ra = vt ? wc : wr, rb = vt ? wr : wc;
    const int row8 = tid >> 3, kq8 = tid & 7;
    const bf16_t* Ag = P + (size_t)(tm * 128 + row8) * LDA + kq8 * 8;
    const bf16_t* Bg = Bt + (size_t)(tn * 128 + row8) * K + kq8 * 8;
    const int ldsw = row8 * 72 + kq8 * 8;
#define GEMM_LOAD(kt_) do { \
        int col_; \
        if (MODE == 0) col_ = (kt_) * 64; \
        else { const int kk0_ = (kt_) * 64; const int seg_ = kk0_ / 384; \
            const int segb_ = seg_ == 0 ? C_AG : (seg_ == 1 ? C_SZ : (seg_ == 2 ? C_CG : C_DG)); col_ = segb_ + (kk0_ - seg_ * 384); } \
        rab0 = *(const uint4*)(Ag + col_); rab1 = *(const uint4*)(Ag + (size_t)32 * LDA + col_); \
        rab2 = *(const uint4*)(Ag + (size_t)64 * LDA + col_); rab3 = *(const uint4*)(Ag + (size_t)96 * LDA + col_); \
        rb0 = *(const uint4*)(Bg + (kt_) * 64); rb1 = *(const uint4*)(Bg + (size_t)32 * K + (kt_) * 64); \
        rb2 = *(const uint4*)(Bg + (size_t)64 * K + (kt_) * 64); rb3 = *(const uint4*)(Bg + (size_t)96 * K + (kt_) * 64); } while (0)
#define GEMM_STORE(buf_) do { \
        bf16_t* a_ = As + (buf_) * 128 * 72 + ldsw; bf16_t* b_ = Bs + (buf_) * 128 * 72 + ldsw; \
        *(uint4*)(a_) = rab0; *(uint4*)(a_ + 32 * 72) = rab1; *(uint4*)(a_ + 64 * 72) = rab2; *(uint4*)(a_ + 96 * 72) = rab3; \
        *(uint4*)(b_) = rb0; *(uint4*)(b_ + 32 * 72) = rb1; *(uint4*)(b_ + 64 * 72) = rb2; *(uint4*)(b_ + 96 * 72) = rb3; } while (0)
#define GEMM_COMPUTE(buf_) do { \
        const bf16_t* a_ = (vt ? Bs : As) + (buf_) * 128 * 72; const bf16_t* b_ = (vt ? As : Bs) + (buf_) * 128 * 72; \
        _Pragma("unroll") for (int ks = 0; ks < 2; ++ks) { \
            bf16x8 af[4], bfr[4]; \
            _Pragma("unroll") for (int mt = 0; mt < 4; ++mt) af[mt] = *(const bf16x8*)(a_ + (ra * 64 + mt * 16 + fr) * 72 + ks * 32 + g * 8); \
            _Pragma("unroll") for (int nt = 0; nt < 4; ++nt) bfr[nt] = *(const bf16x8*)(b_ + (rb * 64 + nt * 16 + fr) * 72 + ks * 32 + g * 8); \
            _Pragma("unroll") for (int mt = 0; mt < 4; ++mt) \
                _Pragma("unroll") for (int nt = 0; nt < 4; ++nt) acc[mt][nt] = mfma16(bfr[nt], af[mt], acc[mt][nt]); \
        } } while (0)

    __syncthreads();
    GEMM_LOAD(0); GEMM_STORE(0);
    __syncthreads();
#pragma unroll 1
    for (int kt = 0; kt < NK - 1; ++kt) {
        const int buf = kt & 1;
        GEMM_LOAD(kt + 1);
        __builtin_amdgcn_sched_barrier(0);
        GEMM_COMPUTE(buf);
        __builtin_amdgcn_sched_barrier(0);
        GEMM_STORE(buf ^ 1);
        __syncthreads();
    }
    GEMM_COMPUTE((NK - 1) & 1);
#undef GEMM_LOAD
#undef GEMM_STORE
#undef GEMM_COMPUTE
    if (nostore && acc[0][0][0] != 12345.678f) return;
    if (MODE == 0) {
        bf16_t* Pw = (bf16_t*)(p.ws + WS_P); float* SM = (float*)(p.ws + WS_SM); bf16_t* halo = (bf16_t*)(p.ws + WS_HALO);
#pragma unroll
        for (int mt = 0; mt < 4; ++mt) {
            const int row = tm * 128 + wr * 64 + mt * 16 + fr;
#pragma unroll
            for (int nt = 0; nt < 4; ++nt) {
                const int col0 = tn * 128 + wc * 64 + nt * 16 + g * 4; const f32x4 v = acc[mt][nt];
                if (vt) {
                    const int n = tn * 128 + wc * 64 + mt * 16 + fr; const int t = tm * 128 + wr * 64 + nt * 16 + g * 4;
                    uint2 o; o.x = pack2(v[0], v[1]); o.y = pack2(v[2], v[3]);
                    *(uint2*)(Pw + (size_t)((t & ~63) + (n & 63)) * LDP + (n & ~63) + (t & 63)) = o;
                } else if (tn < 46) {
                    uint2 o; o.x = pack2(v[0], v[1]); o.y = pack2(v[2], v[3]);
                    *(uint2*)(Pw + (size_t)row * LDP + col0) = o;
                    if (col0 >= C_DQ && col0 < C_DG && (row & 63) >= 61)
                        *(uint2*)(halo + (size_t)((row >> 6) * 3 + (row & 63) - 61) * 1152 + (col0 - C_DQ)) = o;
                } else {
#pragma unroll
                    for (int j = 0; j < 4; ++j) { const int c = col0 - 5888 + j; if (c < 18) SM[(size_t)row * 32 + c] = v[j]; }
                }
            }
        }
    } else {
        const float* resid = (layer == 0) ? p.x : p.out;
#pragma unroll
        for (int mt = 0; mt < 4; ++mt) {
            const int row = tm * 128 + wr * 64 + mt * 16 + fr;
#pragma unroll
            for (int nt = 0; nt < 4; ++nt) {
                const int col0 = tn * 128 + wc * 64 + nt * 16 + g * 4; const f32x4 v = acc[mt][nt];
                const float4 r = *(const float4*)(resid + (size_t)row * 1024 + col0);
                float4 o; o.x = DN_ALPHA * r.x + v[0]; o.y = DN_ALPHA * r.y + v[1]; o.z = DN_ALPHA * r.z + v[2]; o.w = DN_ALPHA * r.w + v[3];
                *(float4*)(p.out + (size_t)row * 1024 + col0) = o;
            }
        }
    }
}

__device__ void ln_unit(const Params& p, int layer, int u) {
    const int tid = opaque_tid(), lane = tid & 63, w = tid >> 6;
    const float* G = p.ln_g + layer * 1024; const float* Bb = p.ln_b + layer * 1024;
    for (int i = 0; i < 8; ++i) {
        float* row = p.out + (size_t)(u * 32 + w * 8 + i) * 1024;
        float4 v[4]; float s = 0.f;
#pragma unroll
        for (int c = 0; c < 4; ++c) { v[c] = *(const float4*)(row + c * 256 + lane * 4); s += (v[c].x + v[c].y) + (v[c].z + v[c].w); }
#pragma unroll
        for (int o = 32; o >= 1; o >>= 1) s += __shfl_xor(s, o);
        const float mu = s * (1.f / 1024.f); float q = 0.f;
#pragma unroll
        for (int c = 0; c < 4; ++c) { float a = v[c].x - mu, b = v[c].y - mu, cc = v[c].z - mu, d = v[c].w - mu; q += (a * a + b * b) + (cc * cc + d * d); }
#pragma unroll
        for (int o = 32; o >= 1; o >>= 1) q += __shfl_xor(q, o);
        const float rstd = rsqrtf(q * (1.f / 1024.f) + 1e-5f);
#pragma unroll
        for (int c = 0; c < 4; ++c) {
            const float4 gg = *(const float4*)(G + c * 256 + lane * 4); const float4 bb = *(const float4*)(Bb + c * 256 + lane * 4);
            float4 o; o.x = (v[c].x - mu) * rstd * gg.x + bb.x; o.y = (v[c].y - mu) * rstd * gg.y + bb.y; o.z = (v[c].z - mu) * rstd * gg.z + bb.z; o.w = (v[c].w - mu) * rstd * gg.w + bb.w;
            *(float4*)(row + c * 256 + lane * 4) = o;
            if (layer == 0) { uint2 xb; xb.x = pack2(o.x, o.y); xb.y = pack2(o.z, o.w); *(uint2*)((bf16_t*)(p.ws + WS_XB) + (size_t)(u * 32 + w * 8 + i) * 1024 + c * 256 + lane * 4) = xb; }
        }
    }
}
__device__ void conv_x_unit(const Params& p, int u) {
    const int tid = opaque_tid(), lane = tid & 63, w = tid >> 6;
    for (int i = 0; i < 8; ++i) {
        const size_t r = (size_t)(u * 32 + w * 8 + i) * 1024;
#pragma unroll
        for (int c = 0; c < 4; ++c) { const float4 v = *(const float4*)(p.x + r + c * 256 + lane * 4); uint2 xb; xb.x = pack2(v.x, v.y); xb.y = pack2(v.z, v.w); *(uint2*)((bf16_t*)(p.ws + WS_XB) + r + c * 256 + lane * 4) = xb; }
    }
}

__device__ void kmean_unit(const Params& p, int u, unsigned char* smem) {
    const int tid = opaque_tid(); const int b = u >> 5, blk = u & 31;
    float* red = (float*)smem;
    const int cgp = tid % 48, rg = tid / 48;
    __syncthreads();
    if (rg < 5) {
        const bf16_t* P = (const bf16_t*)(p.ws + WS_P) + (size_t)(b * SEQ + blk * 256) * LDP + C_AK + cgp * 8;
        float acc[8];
#pragma unroll
        for (int e = 0; e < 8; ++e) acc[e] = 0.f;
#pragma unroll 4
        for (int r = rg; r < 256; r += 5) { float f[8]; unpack8(*(const uint4*)(P + (size_t)r * LDP), f);
#pragma unroll
            for (int e = 0; e < 8; ++e) acc[e] += f[e]; }
#pragma unroll
        for (int e = 0; e < 8; ++e) red[rg * 384 + cgp * 8 + e] = acc[e];
    }
    __syncthreads();
    for (int col = tid; col < 384; col += 256) {
        const float sm = (red[col] + red[384 + col]) + (red[768 + col] + red[1152 + col]) + red[1536 + col];
        const int h = col >> 6, d = col & 63;
        ((float*)(p.ws + WS_KMEAN))[((size_t)(b * 6 + h) * 32 + blk) * 64 + d] = sm * (1.f / 256.f);
    }
}

struct AttnSt { f32x4 o[4]; float m, l; };

template <int NMT, int VS, class F>
__device__ __forceinline__ void attn_tile_g(AttnSt& st, const bf16x8 (&qf)[2], const bf16_t* Kl, const bf16_t* Vt, int lane, F score) {
    const int fr = lane & 15, g = lane >> 4;
    f32x4 s[NMT];
#pragma unroll
    for (int mt = 0; mt < NMT; ++mt) {
        s[mt] = (f32x4){0.f, 0.f, 0.f, 0.f};
#pragma unroll
        for (int ks = 0; ks < 2; ++ks) {
            const bf16x8 a = *(const bf16x8*)(Kl + (mt * 16 + fr) * 72 + ks * 32 + g * 8);
            s[mt] = mfma16(a, qf[ks], s[mt]);
        }
    }
    float mx = -1e30f;
#pragma unroll
    for (int mt = 0; mt < NMT; ++mt)
#pragma unroll
        for (int j = 0; j < 4; ++j) { const float v = score(mt * 16 + g * 4 + j, s[mt][j]); s[mt][j] = v; mx = fmaxf(mx, v); }
    mx = fmaxf(mx, __shfl_xor(mx, 16)); mx = fmaxf(mx, __shfl_xor(mx, 32));
    const float mn = fmaxf(st.m, mx); const float alpha = __expf(st.m - mn);
    float ps = 0.f;
#pragma unroll
    for (int mt = 0; mt < NMT; ++mt)
#pragma unroll
        for (int j = 0; j < 4; ++j) { const float pv = s[mt][j] > -1e29f ? __expf(s[mt][j] - mn) : 0.f; s[mt][j] = pv; ps += pv; }
    ps += __shfl_xor(ps, 16); ps += __shfl_xor(ps, 32);
    st.l = st.l * alpha + ps; st.m = mn;
#pragma unroll
    for (int mt = 0; mt < 4; ++mt) st.o[mt] = st.o[mt] * alpha;
#pragma unroll
    for (int k2 = 0; k2 < NMT / 2; ++k2) {
        union { bf16x8 v; unsigned u[4]; } pbu;
        pbu.u[0] = pack2(s[2 * k2][0], s[2 * k2][1]); pbu.u[1] = pack2(s[2 * k2][2], s[2 * k2][3]);
        pbu.u[2] = pack2(s[2 * k2 + 1][0], s[2 * k2 + 1][1]); pbu.u[3] = pack2(s[2 * k2 + 1][2], s[2 * k2 + 1][3]);
        const bf16x8 pb = pbu.v;
#pragma unroll
        for (int mt = 0; mt < 4; ++mt) {
            const bf16x4 lo = *(const bf16x4*)(Vt + (mt * 16 + fr) * VS + k2 * 32 + g * 4);
            const bf16x4 hi = *(const bf16x4*)(Vt + (mt * 16 + fr) * VS + k2 * 32 + 16 + g * 4);
            bf16x8 a; a[0] = lo[0]; a[1] = lo[1]; a[2] = lo[2]; a[3] = lo[3]; a[4] = hi[0]; a[5] = hi[1]; a[6] = hi[2]; a[7] = hi[3];
            st.o[mt] = mfma16(a, pb, st.o[mt]);
        }
    }
}
template <class F>
__device__ __forceinline__ void attn_tile(AttnSt& st, const bf16x8 (&qf)[2], const bf16_t* Kl, const bf16_t* Vt, int lane, F score) {
    attn_tile_g<4, 72>(st, qf, Kl, Vt, lane, score);
}

__device__ __forceinline__ void attn_tile_past128(AttnSt& st, const bf16x8 (&qf)[2], const bf16_t* Kl, const bf16_t* Vt, int lane, float base2, float slope2) {
    const int fr = lane & 15, g = lane >> 4;
    constexpr float C2 = 0.125f * 1.4426950408889634f;
    f32x4 s[8];
#pragma unroll
    for (int mt = 0; mt < 8; ++mt) {
        s[mt] = (f32x4){0.f, 0.f, 0.f, 0.f};
#pragma unroll
        for (int ks = 0; ks < 2; ++ks) {
            const bf16x8 a = *(const bf16x8*)(Kl + (mt * 16 + fr) * 72 + ks * 32 + g * 8);
            s[mt] = mfma16(a, qf[ks], s[mt]);
        }
    }
    float mx = -1e30f;
#pragma unroll
    for (int mt = 0; mt < 8; ++mt)
#pragma unroll
        for (int j = 0; j < 4; ++j) { const float v = fmaf(s[mt][j], C2, fmaf(slope2, (float)(mt * 16 + j), base2)); s[mt][j] = v; mx = fmaxf(mx, v); }
    mx = fmaxf(mx, __shfl_xor(mx, 16)); mx = fmaxf(mx, __shfl_xor(mx, 32));
    const float mn = fmaxf(st.m, mx); const float alpha = exp2f(st.m - mn);
    float ps = 0.f;
#pragma unroll
    for (int mt = 0; mt < 8; ++mt)
#pragma unroll
        for (int j = 0; j < 4; ++j) { const float pv = __builtin_amdgcn_exp2f(s[mt][j] - mn); s[mt][j] = pv; ps += pv; }
    ps += __shfl_xor(ps, 16); ps += __shfl_xor(ps, 32);
    st.l = st.l * alpha + ps; st.m = mn;
#pragma unroll
    for (int mt = 0; mt < 4; ++mt) st.o[mt] = st.o[mt] * alpha;
#pragma unroll
    for (int k2 = 0; k2 < 4; ++k2) {
        union { bf16x8 v; unsigned u[4]; } pbu;
        pbu.u[0] = pack2(s[2 * k2][0], s[2 * k2][1]); pbu.u[1] = pack2(s[2 * k2][2], s[2 * k2][3]);
        pbu.u[2] = pack2(s[2 * k2 + 1][0], s[2 * k2 + 1][1]); pbu.u[3] = pack2(s[2 * k2 + 1][2], s[2 * k2 + 1][3]);
        const bf16x8 pb = pbu.v;
#pragma unroll
        for (int mt = 0; mt < 4; ++mt) {
            const bf16x4 lo = *(const bf16x4*)(Vt + (mt * 16 + fr) * 136 + k2 * 32 + g * 4);
            const bf16x4 hi = *(const bf16x4*)(Vt + (mt * 16 + fr) * 136 + k2 * 32 + 16 + g * 4);
            bf16x8 a; a[0] = lo[0]; a[1] = lo[1]; a[2] = lo[2]; a[3] = lo[3]; a[4] = hi[0]; a[5] = hi[1]; a[6] = hi[2]; a[7] = hi[3];
            st.o[mt] = mfma16(a, pb, st.o[mt]);
        }
    }
}

template <class TF>
__device__ __forceinline__ void stage_kv(const bf16_t* P, int colK, int colV, bf16_t* Kl, bf16_t* Vt, TF tokfn) {
    const int tid = opaque_tid(), cgp = tid & 7;
#pragma unroll
    for (int i = 0; i < 2; ++i) {
        const int krow = (tid >> 3) + 32 * i; const int tok = tokfn(krow);
        uint4 kv = make_uint4(0, 0, 0, 0), vv = make_uint4(0, 0, 0, 0);
        if (tok >= 0) { kv = *(const uint4*)(P + (size_t)tok * LDP + colK + cgp * 8); vv = *(const uint4*)(P + (size_t)tok * LDP + colV + cgp * 8); }
        *(uint4*)(Kl + krow * 72 + cgp * 8) = kv;
        bf16_t* vt = Vt + (cgp * 8) * 72 + krow;
        vt[0 * 72] = (bf16_t)(vv.x & 0xffff); vt[1 * 72] = (bf16_t)(vv.x >> 16); vt[2 * 72] = (bf16_t)(vv.y & 0xffff); vt[3 * 72] = (bf16_t)(vv.y >> 16);
        vt[4 * 72] = (bf16_t)(vv.z & 0xffff); vt[5 * 72] = (bf16_t)(vv.z >> 16); vt[6 * 72] = (bf16_t)(vv.w & 0xffff); vt[7 * 72] = (bf16_t)(vv.w >> 16);
    }
}

__device__ void moba_unit(const Params& p, int xq, int u, unsigned char* smem, bool dry = false) {
    const int tid = opaque_tid(), lane = tid & 63, w = tid >> 6, fr = lane & 15, g = lane >> 4;
    const int ob = 31 - u / 3; const int strm = 3 * xq + u % 3; const int bh = strm >> 1, hb = strm & 1; const int b = bh / 6, h = bh % 6;
    const int tb = ob * 256 + hb * 128;
    bf16_t* P = (bf16_t*)(p.ws + WS_P);
    bf16_t* Kl = (bf16_t*)smem;
    bf16_t* Vt = (bf16_t*)(smem + 18432);
    float* STO = (float*)(smem + 35840);
    float* kml = STO;
    float* sc = STO + 32 * 64;
    float* STM = (float*)(smem + 68608); float* STL = STM + 128;
    unsigned* selm = (unsigned*)(smem + 69632);
    unsigned* cnt = selm + 128;
    unsigned* off = cnt + 32;
    unsigned* cur = off + 40;
    unsigned* steps = cur + 32;
    int* nstp = (int*)(steps + 96);
    unsigned short* list = (unsigned short*)(steps + 98);
    const float slope = exp2f(-8.f * (float)(7 + h) / 12.f);
    const int cgp = tid & 7, row0 = tid >> 3;
    const int nown = hb + 1;
    const bf16_t* Qg = P + (size_t)(b * SEQ + tb) * LDP + C_AQ + h * 64;
    __syncthreads();
    {
        const float* km = (const float*)(p.ws + WS_KMEAN) + (size_t)(b * 6 + h) * 32 * 64;
        for (int i = tid; i < ob * 64; i += 256) kml[i] = km[i];
    }
    if (tid < 32) cnt[tid] = 0u;
    {
        const int q = tid >> 1, part = tid & 1;
        float qv[64];
#pragma unroll
        for (int e = 0; e < 8; ++e) unpack8(*(const uint4*)(Qg + (size_t)q * LDP + e * 8), qv + e * 8);
        __syncthreads();
        for (int j = part; j < ob; j += 2) {
            float a0 = 0.f;
#pragma unroll
            for (int d = 0; d < 64; ++d) a0 += qv[d] * kml[j * 64 + d];
            sc[q * 33 + j] = a0;
        }
    }
    __syncthreads();
    if (tid < 128) {
        unsigned mask = 0; const int nsel = ob < 3 ? ob : 3;
        for (int r = 0; r < nsel; ++r) {
            float best = 0.f; int bi = -1;
            for (int j = 0; j < ob; ++j) if (!((mask >> j) & 1u)) { const float sv = sc[tid * 33 + j]; if (bi < 0 || sv > best) { best = sv; bi = j; } }
            mask |= 1u << bi; atomicAdd(&cnt[bi], 1u);
        }
        selm[tid] = mask;
    }
    __syncthreads();
    if (tid == 0) {
        unsigned o = 0; int ns = 0;
        for (unsigned r = 0; r < 2; ++r) for (int sb = 0; sb < nown; ++sb) steps[ns++] = 1u | ((unsigned)sb << 1) | (r << 8) | ((unsigned)(ob * 2 + sb) << 16);
        for (int j = 0; j < ob; ++j) {
            const unsigned c = cnt[j]; off[j] = o; cur[j] = o; o += c;
            for (unsigned r = 0; r * 64 < c; ++r)
                for (int sb = 0; sb < 2; ++sb) steps[ns++] = ((unsigned)sb << 1) | ((unsigned)j << 3) | (r << 8) | ((unsigned)(j * 2 + sb) << 16);
        }
        off[ob] = o; *nstp = ns;
    }
    __syncthreads();
    if (tid < 128) {
        unsigned mask = selm[tid];
        while (mask) { const int j = __ffs((int)mask) - 1; mask &= mask - 1; const unsigned pos = atomicAdd(&cur[j], 1u); list[pos] = (unsigned short)tid; }
    }
    __syncthreads();
    const int nsteps = (PROBE == 12 && dry) ? 2 * nown : *nstp;
    uint4 k0, k1, k2, k3, v0, v1, v2, v3;
#define MB_LOAD(kb_) do { const bf16_t* pk_ = P + (size_t)(b * SEQ + (kb_) * 128 + row0) * LDP + h * 64 + cgp * 8; \
        k0 = *(const uint4*)(pk_ + C_AK); k1 = *(const uint4*)(pk_ + (size_t)32 * LDP + C_AK); k2 = *(const uint4*)(pk_ + (size_t)64 * LDP + C_AK); k3 = *(const uint4*)(pk_ + (size_t)96 * LDP + C_AK); \
        v0 = *(const uint4*)(pk_ + C_AV); v1 = *(const uint4*)(pk_ + (size_t)32 * LDP + C_AV); v2 = *(const uint4*)(pk_ + (size_t)64 * LDP + C_AV); v3 = *(const uint4*)(pk_ + (size_t)96 * LDP + C_AV); } while (0)
    MB_LOAD(steps[0] >> 16);
    AttnSt st0; bf16x8 qf0[2], qfn[2];
    int qidx = 0, qidx_n = 0; bool valid = false, wvalid = false, valid_n = false, wvalid_n = false;
    qfn[0] = (bf16x8){0, 0, 0, 0, 0, 0, 0, 0}; qfn[1] = qfn[0];
#pragma unroll 1
    for (int s_ = 0; s_ < nsteps; ++s_) {
        const unsigned stp = steps[s_];
        __syncthreads();
        *(uint4*)(Kl + row0 * 72 + cgp * 8) = k0; *(uint4*)(Kl + (row0 + 32) * 72 + cgp * 8) = k1;
        *(uint4*)(Kl + (row0 + 64) * 72 + cgp * 8) = k2; *(uint4*)(Kl + (row0 + 96) * 72 + cgp * 8) = k3;
        *(uint4*)(Vt + row0 * 136 + cgp * 8) = v0; *(uint4*)(Vt + (row0 + 32) * 136 + cgp * 8) = v1;
        *(uint4*)(Vt + row0 * 136 + 64 + cgp * 8) = v2; *(uint4*)(Vt + (row0 + 32) * 136 + 64 + cgp * 8) = v3;
        __syncthreads();
        if (s_ + 1 < nsteps) {
            const unsigned nst = steps[s_ + 1];
            MB_LOAD(nst >> 16);
            if (!(nst & 1u) && !((nst >> 1) & 1u)) {
                const int j = (nst >> 3) & 31; const int r = (nst >> 8) & 15;
                const int nj = (int)cnt[j]; const int ofs = (int)off[j];
                const int tpos = r * 64 + ((w - j - hb - 2 * (b * 6 + h)) & 3) * 16;
                wvalid_n = tpos < nj; valid_n = tpos + fr < nj;
                int idx = tpos + fr; if (idx > nj - 1) idx = nj - 1;
                qidx_n = (int)list[ofs + idx];
                const bf16_t* qp = Qg + (size_t)qidx_n * LDP + g * 8;
                qfn[0] = *(const bf16x8*)qp; qfn[1] = *(const bf16x8*)(qp + 32);
            }
        }
        __builtin_amdgcn_sched_barrier(0);
        const int sub = (stp >> 1) & 1; const int key0 = (int)(stp >> 16) * 128;
        if (stp & 1u) {
            const int ro = (stp >> 8) & 1;
            const int q0 = ro * 64 + w * 16 + fr;
            if (sub == 0) {
                st0.m = -1e30f; st0.l = 0.f;
#pragma unroll
                for (int mt = 0; mt < 4; ++mt) st0.o[mt] = (f32x4){0.f, 0.f, 0.f, 0.f};
                const bf16_t* qp0 = Qg + (size_t)q0 * LDP + g * 8;
                qf0[0] = *(const bf16x8*)qp0; qf0[1] = *(const bf16x8*)(qp0 + 32);
            }
            const int tq0 = tb + q0;
            attn_tile_g<8, 136>(st0, qf0, Kl, Vt, lane, [&](int key, float raw) { const int kp = key0 + key; return kp <= tq0 ? raw * 0.125f - slope * (float)(tq0 - kp) : -1e30f; });
            if (sub == nown - 1) {
#pragma unroll
                for (int mt = 0; mt < 4; ++mt) *(f32x4*)(STO + q0 * 64 + mt * 16 + g * 4) = st0.o[mt];
                if (g == 0) { STM[q0] = st0.m; STL[q0] = st0.l; }
            }
        } else {
            if (sub == 0) {
                qidx = qidx_n; valid = valid_n; wvalid = wvalid_n; qf0[0] = qfn[0]; qf0[1] = qfn[1];
                st0.m = -1e30f; st0.l = 0.f;
#pragma unroll
                for (int mt = 0; mt < 4; ++mt) st0.o[mt] = (f32x4){0.f, 0.f, 0.f, 0.f};
            }
            if (wvalid && !(PROBE == 13 && dry)) {
                const int tq = tb + qidx;
                const float slope2 = slope * 1.4426950408889634f;
                attn_tile_past128(st0, qf0, Kl, Vt, lane, -slope2 * (float)(tq - key0 - g * 4), slope2);
                if (sub == 1 && valid) {
                    const float mo = STM[qidx], lo = STL[qidx];
                    const float mblk = st0.m * 0.6931471805599453f;
                    const float mn = fmaxf(mo, mblk); const float ao = __expf(mo - mn), an = __expf(mblk - mn);
#pragma unroll
                    for (int mt = 0; mt < 4; ++mt) { f32x4* sp = (f32x4*)(STO + qidx * 64 + mt * 16 + g * 4); *sp = (*sp) * ao + st0.o[mt] * an; }
                    if (g == 0) { STM[qidx] = mn; STL[qidx] = lo * ao + st0.l * an; }
                }
            }
        }
    }
#undef MB_LOAD
    __syncthreads();
    {
        const int q = tid >> 1, hf = tid & 1;
        const float inv = 1.f / STL[q];
        bf16_t* gp = P + (size_t)(b * SEQ + tb + q) * LDP + C_AG + h * 64 + hf * 32;
        const float* so = STO + q * 64 + hf * 32;
#pragma unroll
        for (int e = 0; e < 4; ++e) {
            float gt[8], o[8]; unpack8(*(const uint4*)(gp + e * 8), gt);
#pragma unroll
            for (int k = 0; k < 8; ++k) o[k] = so[e * 8 + k] * inv * silu_f(gt[k]);
            if (!dry) *(uint4*)(gp + e * 8) = pack8(o);
        }
    }
}

__device__ void dil_unit(const Params& p, int cfg, int u, unsigned char* smem, bool dry = false) {
    const int tid = opaque_tid(), lane = tid & 63, w = tid >> 6, fr = lane & 15, g = lane >> 4;
    const int tl = u & 127; const int bh = u >> 7; const int b = bh / 6, h = bh % 6;
    const int d = cfg == 0 ? 1 : (cfg == 1 ? 4 : 16);
    const int tpc = 128 / d; const int r = tl / tpc, sub = tl % tpc; const int qi0 = sub * 64;
    bf16_t* P = (bf16_t*)(p.ws + WS_P);
    bf16_t* Kl = (bf16_t*)smem; bf16_t* Vt = Kl + 64 * 72;
    const float slope = exp2f(-8.f * (float)(h + 1) / 12.f) * (float)d;
    const int qi = qi0 + 16 * w + fr; const int tq = r + d * qi; const size_t tokq = (size_t)b * SEQ + tq;
    bf16x8 qf[2];
    {
        const bf16_t* qp = P + tokq * LDP + C_CQ + h * 64;
        qf[0] = *(const bf16x8*)(qp + g * 8); qf[1] = *(const bf16x8*)(qp + 32 + g * 8);
    }
    AttnSt st; st.m = -1e30f; st.l = 0.f;
#pragma unroll
    for (int mt = 0; mt < 4; ++mt) st.o[mt] = (f32x4){0.f, 0.f, 0.f, 0.f};
    for (int kt = 0; kt < 3; ++kt) {
        const int ki0 = qi0 - 128 + kt * 64;
        if (ki0 + 63 < 0) continue;
        __syncthreads();
        stage_kv(P, C_CK + h * 64, C_CV + h * 64, Kl, Vt, [&](int krow) { const int ki = ki0 + krow; return ki >= 0 ? b * SEQ + r + d * ki : -1; });
        __syncthreads();
        attn_tile(st, qf, Kl, Vt, lane, [&](int key, float raw) {
            const int ki = ki0 + key; const int df = qi - ki;
            const bool ok = (ki >= 0) && (df >= 0) && (df <= 128);
            return ok ? raw * 0.125f - slope * (float)df : -1e30f;
        });
    }
    const float inv = 1.f / st.l; const float lse = st.m + __logf(st.l);
    bf16_t* Op = (bf16_t*)(p.ws + WS_DILO) + tokq * 384 + h * 64;
    float* Lp = (float*)(p.ws + WS_DILL) + tokq * 8 + h;
    float wo = 0.f, wn = 1.f, Ln = lse;
    if (cfg > 0) {
        const float Lo = *Lp; const float mx = fmaxf(Lo, lse);
        Ln = mx + __logf(__expf(Lo - mx) + __expf(lse - mx));
        wo = __expf(Lo - Ln); wn = __expf(lse - Ln);
    }
    const bf16_t* gp = P + tokq * LDP + C_CG + h * 64;
#pragma unroll
    for (int mt = 0; mt < 4; ++mt) {
        const int dv = mt * 16 + g * 4;
        float o0 = st.o[mt][0] * inv * wn, o1 = st.o[mt][1] * inv * wn, o2 = st.o[mt][2] * inv * wn, o3 = st.o[mt][3] * inv * wn;
        if (cfg > 0) { const uint2 ov = *(const uint2*)(Op + dv); o0 += wo * lo2f(ov.x); o1 += wo * hi2f(ov.x); o2 += wo * lo2f(ov.y); o3 += wo * hi2f(ov.y); }
        if (cfg < 2) { uint2 o; o.x = pack2(o0, o1); o.y = pack2(o2, o3); if (!dry) *(uint2*)(Op + dv) = o; }
        else {
            const uint2 gv = *(const uint2*)(gp + dv); uint2 o;
            o.x = pack2(o0 * silu_f(lo2f(gv.x)), o1 * silu_f(hi2f(gv.x))); o.y = pack2(o2 * silu_f(lo2f(gv.y)), o3 * silu_f(hi2f(gv.y)));
            if (!dry) *(uint2*)((bf16_t*)gp + dv) = o;
        }
    }
    if (cfg < 2 && g == 0 && !dry) *Lp = Ln;
}

__device__ __forceinline__ void ssd_dt_acum(const Params& p, int layer, int tok0, int h, float* dtl, float* acum, int wsel = 0) {
    const int tid = opaque_tid() - wsel * 64, lane = tid & 63;
    const float* SM = (const float*)(p.ws + WS_SM);
    if (tid >= 0 && tid < 64) {
        const float bias = p.ssm_dt_bias[layer * 6 + h]; const float A = -__expf(p.ssm_A_log[layer * 6 + h]);
        const float d0 = softplus_f(SM[(size_t)(tok0 + 2 * lane) * 32 + h] + bias), d1 = softplus_f(SM[(size_t)(tok0 + 2 * lane + 1) * 32 + h] + bias);
        const float a0 = d0 * A, a1 = d1 * A;
        const float inc = wave_incl_scan(a0 + a1, lane);
        dtl[2 * lane] = d0; dtl[2 * lane + 1] = d1;
        acum[2 * lane] = inc - a1; acum[2 * lane + 1] = inc;
    }
}

__device__ __forceinline__ void ssd_conv8(const bf16_t* P, const ConvW& cw, int tok, int pos, int col, float* out) {
#pragma unroll
    for (int e = 0; e < 8; ++e) out[e] = cw.b[e];
#pragma unroll
    for (int i = 0; i < 4; ++i) {
        if (pos - 3 + i >= 0) conv_acc(cw, i, *(const uint4*)(P + (size_t)(tok - 3 + i) * LDP + col), out);
    }
#pragma unroll
    for (int e = 0; e < 8; ++e) out[e] = silu_f(out[e]);
}

__device__ void ssd_states_unit(const Params& p, int layer, int u, unsigned char* smem) {
    const int tid = opaque_tid(), lane = tid & 63, w = tid >> 6, fr = lane & 15, g = lane >> 4;
    const int grp = u & 1; const int bc = u >> 1; const int b = bc >> 6, c = bc & 63;
    const int tok0 = b * SEQ + c * 128; const int pos0 = c * 128;
    const bf16_t* P = (const bf16_t*)(p.ws + WS_P);
    bf16_t* BT = (bf16_t*)smem;
    bf16_t* XsT = BT + 128 * 136;
    float* dt3 = (float*)(smem + 52224); float* ac3 = dt3 + 3 * 128;
    const float* CW = p.ssm_conv_w + (size_t)layer * 4 * 896; const float* CB = p.ssm_conv_b + (size_t)layer * 896;
    __syncthreads();
    { const int wv = tid >> 6; if (wv < 3) ssd_dt_acum(p, layer, tok0, grp * 3 + wv, dt3 + wv * 128, ac3 + wv * 128, wv); }
    {
        const int cgp = tid & 15; ConvW cw; load_convw(cw, CW, CB, 896, 384 + grp * 128 + cgp * 8);
#pragma unroll 2
        for (int i = 0; i < 8; ++i) {
            const int l = (tid >> 4) + 16 * i; float o[8];
            ssd_conv8(P, cw, tok0 + l, pos0 + l, C_SB + grp * 128 + cgp * 8, o);
#pragma unroll
            for (int e = 0; e < 8; ++e) BT[(cgp * 8 + e) * 136 + l] = f2bf(o[e]);
        }
    }
    bf16_t* ST = (bf16_t*)(p.ws + WS_ST);
    for (int hh = 0; hh < 3; ++hh) {
        const int h = grp * 3 + hh;
        const float* dtl = dt3 + hh * 128; const float* acum = ac3 + hh * 128;
        __syncthreads();
        {
            const int cgp = tid & 7; ConvW cw; load_convw(cw, CW, CB, 896, h * 64 + cgp * 8);
            const float alast = acum[127];
            for (int i = 0; i < 4; ++i) {
                const int l = (tid >> 3) + 32 * i; float o[8];
                ssd_conv8(P, cw, tok0 + l, pos0 + l, C_SX + h * 64 + cgp * 8, o);
                const float sc = dtl[l] * __expf(alast - acum[l]);
#pragma unroll
                for (int e = 0; e < 8; ++e) XsT[(cgp * 8 + e) * 136 + l] = f2bf(o[e] * sc);
            }
            if (tid == 0) ((float*)(p.ws + WS_CDEC))[(size_t)(b * 64 + c) * 8 + h] = __expf(alast);
        }
        __syncthreads();
        f32x4 acc[2][4];
#pragma unroll
        for (int mt = 0; mt < 2; ++mt)
#pragma unroll
            for (int nt = 0; nt < 4; ++nt) acc[mt][nt] = (f32x4){0.f, 0.f, 0.f, 0.f};
#pragma unroll
        for (int ks = 0; ks < 4; ++ks) {
            bf16x8 a[2], bb[4];
#pragma unroll
            for (int mt = 0; mt < 2; ++mt) a[mt] = *(const bf16x8*)(BT + (32 * w + mt * 16 + fr) * 136 + ks * 32 + g * 8);
#pragma unroll
            for (int nt = 0; nt < 4; ++nt) bb[nt] = *(const bf16x8*)(XsT + (nt * 16 + fr) * 136 + ks * 32 + g * 8);
#pragma unroll
            for (int mt = 0; mt < 2; ++mt)
#pragma unroll
                for (int nt = 0; nt < 4; ++nt) acc[mt][nt] = mfma16(a[mt], bb[nt], acc[mt][nt]);
        }
        bf16_t* dst = ST + ((size_t)((b * 64 + c) * 6 + h)) * 8192;
#pragma unroll
        for (int mt = 0; mt < 2; ++mt)
#pragma unroll
            for (int nt = 0; nt < 4; ++nt) {
                const int n = 32 * w + mt * 16 + g * 4, pp = nt * 16 + fr;
                uint2 o; o.x = pack2(acc[mt][nt][0], acc[mt][nt][1]); o.y = pack2(acc[mt][nt][2], acc[mt][nt][3]);
                *(uint2*)(dst + pp * 128 + n) = o;
            }
    }
}

__device__ void ssd_scan_unit(const Params& p, int u) {
    const int gid = u * 256 + opaque_tid(); const int bh = gid >> 10, e8 = gid & 1023; const int b = bh / 6, h = bh % 6;
    bf16_t* ST = (bf16_t*)(p.ws + WS_ST); const float* CD = (const float*)(p.ws + WS_CDEC);
    float hr[8];
#pragma unroll
    for (int e = 0; e < 8; ++e) hr[e] = 0.f;
#pragma unroll 4
    for (int c = 0; c < 64; ++c) {
        bf16_t* a = ST + ((size_t)((b * 64 + c) * 6 + h)) * 8192 + e8 * 8;
        const uint4 v = *(const uint4*)a; float s[8]; unpack8(v, s);
        const float dec = CD[(size_t)(b * 64 + c) * 8 + h];
        *(uint4*)a = pack8(hr);
#pragma unroll
        for (int e = 0; e < 8; ++e) hr[e] = hr[e] * dec + s[e];
    }
}

__device__ void ssd_out_unit(const Params& p, int layer, int u, unsigned char* smem, bool dry = false) {
    const int tid = opaque_tid(), lane = tid & 63, w = tid >> 6, fr = lane & 15, g = lane >> 4;
    const int half = u & 1; const int bc = u >> 1; const int b = bc >> 6, c = bc & 63;
    const int tok0 = b * SEQ + c * 128; const int pos0 = c * 128; const int l0 = half * 64;
    bf16_t* P = (bf16_t*)(p.ws + WS_P);
    bf16_t* Ch = (bf16_t*)smem;
    bf16_t* Bb = Ch + 64 * 136;
    bf16_t* Gb = Bb + 64 * 136;
    bf16_t* XT = Gb + 64 * 136;
    float* red = (float*)(smem + 69632);
    float* dt6 = (float*)(smem + 71680);
    float* ac6 = dt6 + 6 * 128;
    const float* CW = p.ssm_conv_w + (size_t)layer * 4 * 896; const float* CB = p.ssm_conv_b + (size_t)layer * 896;
    const bf16_t* ST = (const bf16_t*)(p.ws + WS_ST);
    float ssq[4] = {0.f, 0.f, 0.f, 0.f};
    const int nsb = half + 1;
    __syncthreads();
    {
        const int wv = tid >> 6;
        ssd_dt_acum(p, layer, tok0, wv, dt6 + wv * 128, ac6 + wv * 128, wv);
        if (wv + 4 < 6) ssd_dt_acum(p, layer, tok0, wv + 4, dt6 + (wv + 4) * 128, ac6 + (wv + 4) * 128, wv);
    }
#pragma unroll 1
    for (int grp = 0; grp < 2; ++grp) {
        __syncthreads();
        {
            const int cgp = tid & 15; ConvW cw; load_convw(cw, CW, CB, 896, 640 + grp * 128 + cgp * 8);
#pragma unroll 1
            for (int i = 0; i < 4; ++i) {
                const int l = (tid >> 4) + 16 * i; float o[8];
                ssd_conv8(P, cw, tok0 + l0 + l, pos0 + l0 + l, C_SC + grp * 128 + cgp * 8, o);
                *(uint4*)(Ch + l * 136 + cgp * 8) = pack8(o);
            }
        }
        f32x4 G0[2][4];
#pragma unroll 1
        for (int sb = 0; sb < nsb; ++sb) {
            __syncthreads();
            {
                const int cgp = tid & 15; ConvW cw; load_convw(cw, CW, CB, 896, 384 + grp * 128 + cgp * 8);
#pragma unroll 1
                for (int i = 0; i < 4; ++i) {
                    const int s = (tid >> 4) + 16 * i; float o[8];
                    ssd_conv8(P, cw, tok0 + sb * 64 + s, pos0 + sb * 64 + s, C_SB + grp * 128 + cgp * 8, o);
                    *(uint4*)(Bb + s * 136 + cgp * 8) = pack8(o);
                }
            }
            __syncthreads();
            f32x4 acc[4];
#pragma unroll
            for (int nt = 0; nt < 4; ++nt) acc[nt] = (f32x4){0.f, 0.f, 0.f, 0.f};
#pragma unroll
            for (int ks = 0; ks < 4; ++ks) {
                const bf16x8 a = *(const bf16x8*)(Bb + (16 * w + fr) * 136 + ks * 32 + g * 8);
#pragma unroll
                for (int nt = 0; nt < 4; ++nt) { const bf16x8 bb = *(const bf16x8*)(Ch + (nt * 16 + fr) * 136 + ks * 32 + g * 8); acc[nt] = mfma16(a, bb, acc[nt]); }
            }
            if (sb == 0) {
#pragma unroll
                for (int nt = 0; nt < 4; ++nt) G0[0][nt] = acc[nt];
            } else {
#pragma unroll
                for (int nt = 0; nt < 4; ++nt) G0[1][nt] = acc[nt];
            }
        }
#pragma unroll 1
        for (int hh = 0; hh < 3; ++hh) {
            const int h = grp * 3 + hh;
            const float* dtl = dt6 + h * 128; const float* acum = ac6 + h * 128;
            __syncthreads();
#pragma unroll
            for (int sb = 0; sb < 2; ++sb) {
                if (sb < nsb) {
#pragma unroll
                    for (int nt = 0; nt < 4; ++nt) {
                        const int l = l0 + nt * 16 + fr; const float al = acum[l]; float v[4];
#pragma unroll
                        for (int j = 0; j < 4; ++j) { const int s = sb * 64 + 16 * w + g * 4 + j; v[j] = (s <= l) ? G0[sb][nt][j] * __expf(al - acum[s]) * dtl[s] : 0.f; }
                        uint2 o; o.x = pack2(v[0], v[1]); o.y = pack2(v[2], v[3]);
                        *(uint2*)(Gb + (nt * 16 + fr) * 136 + sb * 64 + 16 * w + g * 4) = o;
                    }
                }
            }
            {
                const int cgp = tid & 7; ConvW cw; load_convw(cw, CW, CB, 896, h * 64 + cgp * 8);
#pragma unroll 1
                for (int i = 0; i < 2 * nsb; ++i) {
                    const int s = (tid >> 3) + 32 * i; float o[8];
                    ssd_conv8(P, cw, tok0 + s, pos0 + s, C_SX + h * 64 + cgp * 8, o);
#pragma unroll
                    for (int e = 0; e < 8; ++e) XT[(cgp * 8 + e) * 136 + s] = f2bf(o[e]);
                }
            }
            {
                const bf16_t* src = ST + ((size_t)((b * 64 + c) * 6 + h)) * 8192;
#pragma unroll
                for (int i = 0; i < 4; ++i) { const int idx = tid + 256 * i; const int pp = idx >> 4, nq = idx & 15; *(uint4*)(Bb + pp * 136 + nq * 8) = *(const uint4*)(src + pp * 128 + nq * 8); }
            }
            __syncthreads();
            f32x4 a1[4], a2[4];
#pragma unroll
            for (int nt = 0; nt < 4; ++nt) { a1[nt] = (f32x4){0.f, 0.f, 0.f, 0.f}; a2[nt] = (f32x4){0.f, 0.f, 0.f, 0.f}; }
#pragma unroll
            for (int ks = 0; ks < 4; ++ks) {
                const bf16x8 a = *(const bf16x8*)(Bb + (16 * w + fr) * 136 + ks * 32 + g * 8);
#pragma unroll
                for (int nt = 0; nt < 4; ++nt) { const bf16x8 bb = *(const bf16x8*)(Ch + (nt * 16 + fr) * 136 + ks * 32 + g * 8); a1[nt] = mfma16(a, bb, a1[nt]); }
            }
#pragma unroll 1
            for (int ks = 0; ks < 2 * nsb; ++ks) {
                const bf16x8 a = *(const bf16x8*)(XT + (16 * w + fr) * 136 + ks * 32 + g * 8);
#pragma unroll
                for (int nt = 0; nt < 4; ++nt) { const bf16x8 bb = *(const bf16x8*)(Gb + (nt * 16 + fr) * 136 + ks * 32 + g * 8); a2[nt] = mfma16(a, bb, a2[nt]); }
            }
            const float Dh = p.ssm_D[layer * 6 + h];
#pragma unroll
            for (int nt = 0; nt < 4; ++nt) {
                const int l = nt * 16 + fr; const float ea = __expf(acum[l0 + l]);
                bf16_t* zp = P + (size_t)(tok0 + l0 + l) * LDP + C_SZ + h * 64 + 16 * w + g * 4;
                const uint2 zv = *(const uint2*)zp; float z[4] = {lo2f(zv.x), hi2f(zv.x), lo2f(zv.y), hi2f(zv.y)}; float y[4];
#pragma unroll
                for (int j = 0; j < 4; ++j) {
                    const float xs = bf2f(XT[(16 * w + g * 4 + j) * 136 + l0 + l]);
                    y[j] = (a1[nt][j] * ea + a2[nt][j] + Dh * xs) * silu_f(z[j]);
                    ssq[nt] += y[j] * y[j];
                }
                uint2 o; o.x = pack2(y[0], y[1]); o.y = pack2(y[2], y[3]);
                if (!dry) *(uint2*)zp = o;
            }
        }
    }
#pragma unroll
    for (int nt = 0; nt < 4; ++nt) { ssq[nt] += __shfl_xor(ssq[nt], 16); ssq[nt] += __shfl_xor(ssq[nt], 32); }
    __syncthreads();
    if (g == 0) {
#pragma unroll
        for (int nt = 0; nt < 4; ++nt) red[w * 64 + nt * 16 + fr] = ssq[nt];
    }
    __syncthreads();
    const float* NW = p.ssm_norm_w + layer * 384;
#pragma unroll
    for (int nt = 0; nt < 4; ++nt) {
        const int l = nt * 16 + fr;
        const float tot = red[l] + red[64 + l] + red[128 + l] + red[192 + l];
        const float rstd = rsqrtf(tot * (1.f / 384.f) + 1e-6f);
#pragma unroll 1
        for (int h = 0; h < 6; ++h) {
            bf16_t* zp = P + (size_t)(tok0 + l0 + l) * LDP + C_SZ + h * 64 + 16 * w + g * 4;
            const uint2 zv = *(const uint2*)zp; const float4 nw = *(const float4*)(NW + h * 64 + 16 * w + g * 4);
            uint2 o; o.x = pack2(lo2f(zv.x) * rstd * nw.x, hi2f(zv.x) * rstd * nw.y); o.y = pack2(lo2f(zv.y) * rstd * nw.z, hi2f(zv.y) * rstd * nw.w);
            if (!dry) *(uint2*)zp = o;
        }
    }
}

__device__ void delta_prep_unit(const Params& p, int layer, int u, unsigned char* smem, bool dry = false) {
    const int tid = opaque_tid(), lane = tid & 63, w = tid >> 6, fr = lane & 15, g = lane >> 4;
    const int h = u % 6; const int bc = u / 6; const int c = bc & 127; const int tok0 = bc * 64;
    bf16_t* P = (bf16_t*)(p.ws + WS_P);
    const bf16_t* halo = (const bf16_t*)(p.ws + WS_HALO);
    bf16_t* q16 = (bf16_t*)smem; bf16_t* k16 = q16 + 64 * 72;
    float* X = (float*)(smem + 18432);
    float* Lm = (float*)(smem + 51200);
    float* gcl = (float*)(smem + 67584); float* betal = gcl + 64;
    const float* SM = (const float*)(p.ws + WS_SM);
    const float* CW = p.dn_conv_w + (size_t)layer * 4 * 1152; const float* CB = p.dn_conv_b + (size_t)layer * 1152;
    __syncthreads();
    if (tid < 64) {
        const float bt = 1.f / (1.f + __expf(-SM[(size_t)(tok0 + tid) * 32 + 6 + h]));
        const float gv = -__expf(p.dn_A_log[layer * 6 + h]) * softplus_f(SM[(size_t)(tok0 + tid) * 32 + 12 + h] + p.dn_dt_bias[layer * 6 + h]);
        const float gc = wave_incl_scan(gv, lane);
        gcl[tid] = gc; betal[tid] = bt;
        ((float*)(p.ws + WS_GC))[(size_t)(tok0 + tid) * 8 + h] = gc;
    }
    __syncthreads();
    const int cgp = tid & 7;
#pragma unroll 1
    for (int mat = 0; mat < 3; ++mat) {
        ConvW cw; load_convw(cw, CW, CB, 1152, mat * 384 + h * 64 + cgp * 8);
        const int col = C_DQ + mat * 384 + h * 64 + cgp * 8;
#pragma unroll
        for (int i = 0; i < 2; ++i) {
            const int row = (tid >> 3) + 32 * i; float o[8];
#pragma unroll
            for (int e = 0; e < 8; ++e) o[e] = cw.b[e];
#pragma unroll
            for (int t = 0; t < 4; ++t) {
                const int rr = row - 3 + t;
                if (rr >= 0) conv_acc(cw, t, *(const uint4*)(P + (size_t)(tok0 + rr) * LDP + col), o);
                else if (c > 0) conv_acc(cw, t, *(const uint4*)(halo + (size_t)((bc - 1) * 3 + rr + 3) * 1152 + mat * 384 + h * 64 + cgp * 8), o);
            }
            float ss = 0.f;
#pragma unroll
            for (int e = 0; e < 8; ++e) { o[e] = silu_f(o[e]); ss += o[e] * o[e]; }
            ss += __shfl_xor(ss, 1); ss += __shfl_xor(ss, 2); ss += __shfl_xor(ss, 4);
            const float rinv = rsqrtf(ss + 1e-6f);
            if (mat == 0) {
#pragma unroll
                for (int e = 0; e < 8; ++e) o[e] *= rinv * 0.125f;
                *(uint4*)(q16 + row * 72 + cgp * 8) = pack8(o);
            } else if (mat == 1) {
                const float sc = betal[row] * __expf(gcl[row]);
#pragma unroll
                for (int e = 0; e < 8; ++e) { o[e] *= rinv; X[row * 128 + 64 + cgp * 8 + e] = o[e] * sc; }
                *(uint4*)(k16 + row * 72 + cgp * 8) = pack8(o);
            } else {
                const float bt = betal[row];
#pragma unroll
                for (int e = 0; e < 8; ++e) X[row * 128 + cgp * 8 + e] = o[e] * bt;
            }
        }
    }
    __syncthreads();
    {
        f32x4 acc[4];
#pragma unroll
        for (int nt = 0; nt < 4; ++nt) acc[nt] = (f32x4){0.f, 0.f, 0.f, 0.f};
#pragma unroll
        for (int ks = 0; ks < 2; ++ks) {
            const bf16x8 a = *(const bf16x8*)(k16 + (16 * w + fr) * 72 + ks * 32 + g * 8);
#pragma unroll
            for (int nt = 0; nt < 4; ++nt) { const bf16x8 bb = *(const bf16x8*)(k16 + (nt * 16 + fr) * 72 + ks * 32 + g * 8); acc[nt] = mfma16(a, bb, acc[nt]); }
        }
#pragma unroll
        for (int nt = 0; nt < 4; ++nt)
#pragma unroll
            for (int j = 0; j < 4; ++j) {
                const int i = 16 * w + g * 4 + j, jj = nt * 16 + fr;
                Lm[i * 64 + jj] = (jj < i) ? acc[nt][j] * betal[i] * __expf(gcl[i] - gcl[jj]) : 0.f;
            }
    }
    __syncthreads();
    if (tid < 128) {
        float xr[64];
#pragma unroll
        for (int i = 0; i < 64; ++i) xr[i] = X[i * 128 + tid];
#pragma unroll
        for (int i = 1; i < 64; ++i) {
            float a0 = 0.f, a1 = 0.f, a2 = 0.f, a3 = 0.f;
#pragma unroll
            for (int j = 0; j < i; ++j) {
                const float lv = Lm[i * 64 + j];
                if ((j & 3) == 0) a0 += lv * xr[j]; else if ((j & 3) == 1) a1 += lv * xr[j]; else if ((j & 3) == 2) a2 += lv * xr[j]; else a3 += lv * xr[j];
            }
            xr[i] -= (a0 + a1) + (a2 + a3);
        }
#pragma unroll
        for (int i = 1; i < 64; ++i) X[i * 128 + tid] = xr[i];
    }
    __syncthreads();
    bf16_t* WB = (bf16_t*)(p.ws + WS_WB);
    if (!dry)
#pragma unroll
    for (int i = 0; i < 2; ++i) {
        const int row = (tid >> 3) + 32 * i;
        bf16_t* pr = P + (size_t)(tok0 + row) * LDP + h * 64 + cgp * 8;
        *(uint4*)(pr + C_DQ) = *(const uint4*)(q16 + row * 72 + cgp * 8);
        *(uint4*)(pr + C_DK) = *(const uint4*)(k16 + row * 72 + cgp * 8);
        *(uint4*)(pr + C_DV) = pack8(X + row * 128 + cgp * 8);
        *(uint4*)(WB + (size_t)(tok0 + row) * 384 + h * 64 + cgp * 8) = pack8(X + row * 128 + 64 + cgp * 8);
    }
    bf16_t* kdT = (bf16_t*)Lm; bf16_t* uT = (bf16_t*)(smem + 68608);
    {
        const float gl = gcl[63];
#pragma unroll
        for (int i = 0; i < 2; ++i) {
            const int row = (tid >> 3) + 32 * i;
            float kf[8]; unpack8(*(const uint4*)(k16 + row * 72 + cgp * 8), kf);
            const float sc = __expf(gl - gcl[row]);
#pragma unroll
            for (int e = 0; e < 8; ++e) { kdT[(cgp * 8 + e) * 72 + row] = f2bf(kf[e] * sc); uT[(cgp * 8 + e) * 72 + row] = f2bf(X[row * 128 + cgp * 8 + e]); }
        }
    }
    __syncthreads();
    {
        f32x4 acc[4];
#pragma unroll
        for (int nt = 0; nt < 4; ++nt) acc[nt] = (f32x4){0.f, 0.f, 0.f, 0.f};
#pragma unroll
        for (int ks = 0; ks < 2; ++ks) {
            const bf16x8 a = *(const bf16x8*)(kdT + (16 * w + fr) * 72 + ks * 32 + g * 8);
#pragma unroll
            for (int nt = 0; nt < 4; ++nt) { const bf16x8 bb = *(const bf16x8*)(uT + (nt * 16 + fr) * 72 + ks * 32 + g * 8); acc[nt] = mfma16(a, bb, acc[nt]); }
        }
        bf16_t* QB = (bf16_t*)(p.ws + WS_QB) + ((size_t)bc * 6 + h) * 4096;
        if (!dry)
#pragma unroll
        for (int nt = 0; nt < 4; ++nt) { uint2 o; o.x = pack2(acc[nt][0], acc[nt][1]); o.y = pack2(acc[nt][2], acc[nt][3]); *(uint2*)(QB + (nt * 16 + fr) * 64 + 16 * w + g * 4) = o; }
    }
}

__device__ void delta_scan_unit(const Params& p, int layer, int u, unsigned char* smem, bool dry = false) {
    const int tid = opaque_tid(), lane = tid & 63, w = tid >> 6, fr = lane & 15, g = lane >> 4;
    const int b = u / 6, h = u % 6;
    const bf16_t* P = (const bf16_t*)(p.ws + WS_P);
    const bf16_t* WB = (const bf16_t*)(p.ws + WS_WB); const float* GC = (const float*)(p.ws + WS_GC);
    const bf16_t* QB = (const bf16_t*)(p.ws + WS_QB); bf16_t* SB = (bf16_t*)(p.ws + WS_SB);
    bf16_t* w16 = (bf16_t*)smem; bf16_t* kdT = w16 + 64 * 72; bf16_t* St = kdT + 64 * 72; bf16_t* wsT = St + 64 * 72;
    f32x4 S[4];
#pragma unroll
    for (int nt = 0; nt < 4; ++nt) S[nt] = (f32x4){0.f, 0.f, 0.f, 0.f};
    __syncthreads();
    for (int i = tid; i < 64 * 72 / 2; i += 256) ((unsigned*)St)[i] = 0u;
    const int cgp = tid & 7, row0 = tid >> 3;
    uint4 wv0, wv1, kv0, kv1; float gr0, gr1, gl; uint2 qr[4];
#define DS_PREFETCH(c_) do { const int tk_ = b * SEQ + (c_) * 64; \
        const bf16_t* pr_ = P + (size_t)(tk_ + row0) * LDP + C_DK + h * 64 + cgp * 8; \
        kv0 = *(const uint4*)pr_; kv1 = *(const uint4*)(pr_ + (size_t)32 * LDP); \
        const bf16_t* wr_ = WB + (size_t)(tk_ + row0) * 384 + h * 64 + cgp * 8; \
        wv0 = *(const uint4*)wr_; wv1 = *(const uint4*)(wr_ + 32 * 384); \
        gr0 = GC[(size_t)(tk_ + row0) * 8 + h]; gr1 = GC[(size_t)(tk_ + row0 + 32) * 8 + h]; gl = GC[(size_t)(tk_ + 63) * 8 + h]; \
        const bf16_t* qb_ = QB + ((size_t)(b * 128 + (c_)) * 6 + h) * 4096 + 16 * w + g * 4; \
        _Pragma("unroll") for (int nt = 0; nt < 4; ++nt) qr[nt] = *(const uint2*)(qb_ + (nt * 16 + fr) * 64); } while (0)
    DS_PREFETCH(0);
#pragma unroll 1
    for (int c = 0; c < 128; ++c) {
        __syncthreads();
        *(uint4*)(w16 + row0 * 72 + cgp * 8) = wv0; *(uint4*)(w16 + (row0 + 32) * 72 + cgp * 8) = wv1;
        {
            float kf[8]; unpack8(kv0, kf); float sc = __expf(gl - gr0);
            const int c0 = row0 ^ (cgp * 8), c1 = (row0 + 32) ^ (cgp * 8);
#pragma unroll
            for (int e = 0; e < 8; e += 2) { const unsigned pk = pack2(kf[e] * sc, kf[e + 1] * sc); kdT[(cgp * 8 + e) * 72 + c0] = (bf16_t)(pk & 0xffff); kdT[(cgp * 8 + e + 1) * 72 + c0] = (bf16_t)(pk >> 16); }
            unpack8(kv1, kf); sc = __expf(gl - gr1);
#pragma unroll
            for (int e = 0; e < 8; e += 2) { const unsigned pk = pack2(kf[e] * sc, kf[e + 1] * sc); kdT[(cgp * 8 + e) * 72 + c1] = (bf16_t)(pk & 0xffff); kdT[(cgp * 8 + e + 1) * 72 + c1] = (bf16_t)(pk >> 16); }
        }
        const float eg = __expf(gl);
        float qc[4][4];
#pragma unroll
        for (int nt = 0; nt < 4; ++nt) { qc[nt][0] = lo2f(qr[nt].x); qc[nt][1] = hi2f(qr[nt].x); qc[nt][2] = lo2f(qr[nt].y); qc[nt][3] = hi2f(qr[nt].y); }
        __syncthreads();
        if (c + 1 < 128) DS_PREFETCH(c + 1);
        __builtin_amdgcn_sched_barrier(0);
        if (!dry) {
            bf16_t* sb = SB + ((size_t)(b * 128 + c) * 6 + h) * 4096 + 16 * w + g * 4;
#pragma unroll
            for (int nt = 0; nt < 4; ++nt) { uint2 o; o.x = pack2(S[nt][0], S[nt][1]); o.y = pack2(S[nt][2], S[nt][3]); *(uint2*)(sb + (nt * 16 + fr) * 64) = o; }
        }
        __builtin_amdgcn_sched_barrier(0);
        {
            f32x4 acc[4];
#pragma unroll
            for (int nt = 0; nt < 4; ++nt) acc[nt] = (f32x4){0.f, 0.f, 0.f, 0.f};
#pragma unroll
            for (int ks = 0; ks < 2; ++ks) {
                const bf16x8 a = *(const bf16x8*)(w16 + (16 * w + fr) * 72 + ks * 32 + g * 8);
#pragma unroll
                for (int nt = 0; nt < 4; ++nt) { const bf16x8 bb = *(const bf16x8*)(St + (nt * 16 + fr) * 72 + ks * 32 + g * 8); acc[nt] = mfma16(a, bb, acc[nt]); }
            }
#pragma unroll
            for (int nt = 0; nt < 4; ++nt) { uint2 o; o.x = pack2(acc[nt][0], acc[nt][1]); o.y = pack2(acc[nt][2], acc[nt][3]); *(uint2*)(wsT + (nt * 16 + fr) * 72 + 16 * w + g * 4) = o; }
        }
        __syncthreads();
        {
            f32x4 acc[4];
#pragma unroll
            for (int nt = 0; nt < 4; ++nt) acc[nt] = (f32x4){0.f, 0.f, 0.f, 0.f};
#pragma unroll
            for (int ks = 0; ks < 2; ++ks) {
                const bf16x8 a = *(const bf16x8*)(kdT + (16 * w + fr) * 72 + ((ks * 32 + g * 8) ^ (((2 * w + (fr >> 3)) & 7) << 3)));
#pragma unroll
                for (int nt = 0; nt < 4; ++nt) { const bf16x8 bb = *(const bf16x8*)(wsT + (nt * 16 + fr) * 72 + ks * 32 + g * 8); acc[nt] = mfma16(a, bb, acc[nt]); }
            }
#pragma unroll
            for (int nt = 0; nt < 4; ++nt) {
#pragma unroll
                for (int j = 0; j < 4; ++j) S[nt][j] = S[nt][j] * eg + qc[nt][j] - acc[nt][j];
                uint2 o; o.x = pack2(S[nt][0], S[nt][1]); o.y = pack2(S[nt][2], S[nt][3]); *(uint2*)(St + (nt * 16 + fr) * 72 + 16 * w + g * 4) = o;
            }
        }
    }
#undef DS_PREFETCH
}

__device__ void delta_out_unit(const Params& p, int layer, int u, unsigned char* smem, bool dry = false) {
    const int tid = opaque_tid(), lane = tid & 63, w = tid >> 6, fr = lane & 15, g = lane >> 4;
    const int h = u % 6; const int bc = u / 6; const int tok0 = bc * 64;
    bf16_t* P = (bf16_t*)(p.ws + WS_P);
    const bf16_t* WB = (const bf16_t*)(p.ws + WS_WB); const float* GC = (const float*)(p.ws + WS_GC);
    const bf16_t* SB = (const bf16_t*)(p.ws + WS_SB) + ((size_t)bc * 6 + h) * 4096;
    bf16_t* q16 = (bf16_t*)smem; bf16_t* k16 = q16 + 64 * 72; bf16_t* w16 = k16 + 64 * 72; bf16_t* St = w16 + 64 * 72;
    bf16_t* att = St + 64 * 72; bf16_t* vnT = att + 64 * 72; bf16_t* u16 = vnT + 64 * 72;
    float* gcl = (float*)(smem + 64512);
    const int cgp = tid & 7;
    __syncthreads();
#pragma unroll
    for (int i = 0; i < 2; ++i) {
        const int row = (tid >> 3) + 32 * i;
        const bf16_t* pr = P + (size_t)(tok0 + row) * LDP + h * 64 + cgp * 8;
        *(uint4*)(q16 + row * 72 + cgp * 8) = *(const uint4*)(pr + C_DQ);
        *(uint4*)(k16 + row * 72 + cgp * 8) = *(const uint4*)(pr + C_DK);
        *(uint4*)(u16 + row * 72 + cgp * 8) = *(const uint4*)(pr + C_DV);
        *(uint4*)(w16 + row * 72 + cgp * 8) = *(const uint4*)(WB + (size_t)(tok0 + row) * 384 + h * 64 + cgp * 8);
        *(uint4*)(St + row * 72 + cgp * 8) = *(const uint4*)(SB + row * 64 + cgp * 8);
        if (cgp == 0) gcl[row] = GC[(size_t)(tok0 + row) * 8 + h];
    }
    float gt[4][4];
#pragma unroll
    for (int nt = 0; nt < 4; ++nt)
#pragma unroll
        for (int j = 0; j < 4; ++j) gt[nt][j] = bf2f(P[(size_t)(tok0 + 16 * w + g * 4 + j) * LDP + C_DG + h * 64 + nt * 16 + fr]);
    __syncthreads();
    {
        f32x4 acc[4];
#pragma unroll
        for (int nt = 0; nt < 4; ++nt) acc[nt] = (f32x4){0.f, 0.f, 0.f, 0.f};
#pragma unroll
        for (int ks = 0; ks < 2; ++ks) {
            const bf16x8 a = *(const bf16x8*)(k16 + (16 * w + fr) * 72 + ks * 32 + g * 8);
#pragma unroll
            for (int nt = 0; nt < 4; ++nt) { const bf16x8 bb = *(const bf16x8*)(q16 + (nt * 16 + fr) * 72 + ks * 32 + g * 8); acc[nt] = mfma16(a, bb, acc[nt]); }
        }
#pragma unroll
        for (int nt = 0; nt < 4; ++nt) {
            const int i = nt * 16 + fr; const float gi = gcl[i]; float v[4];
#pragma unroll
            for (int jj = 0; jj < 4; ++jj) { const int j = 16 * w + g * 4 + jj; v[jj] = (j <= i) ? acc[nt][jj] * __expf(gi - gcl[j]) : 0.f; }
            uint2 o; o.x = pack2(v[0], v[1]); o.y = pack2(v[2], v[3]);
            *(uint2*)(att + i * 72 + 16 * w + g * 4) = o;
        }
    }
    {
        f32x4 acc[4];
#pragma unroll
        for (int nt = 0; nt < 4; ++nt) acc[nt] = (f32x4){0.f, 0.f, 0.f, 0.f};
#pragma unroll
        for (int ks = 0; ks < 2; ++ks) {
            const bf16x8 a = *(const bf16x8*)(w16 + (16 * w + fr) * 72 + ks * 32 + g * 8);
#pragma unroll
            for (int nt = 0; nt < 4; ++nt) { const bf16x8 bb = *(const bf16x8*)(St + (nt * 16 + fr) * 72 + ks * 32 + g * 8); acc[nt] = mfma16(a, bb, acc[nt]); }
        }
#pragma unroll
        for (int nt = 0; nt < 4; ++nt) {
            float v[4];
#pragma unroll
            for (int j = 0; j < 4; ++j) v[j] = bf2f(u16[(16 * w + g * 4 + j) * 72 + nt * 16 + fr]) - acc[nt][j];
            uint2 o; o.x = pack2(v[0], v[1]); o.y = pack2(v[2], v[3]);
            *(uint2*)(vnT + (nt * 16 + fr) * 72 + 16 * w + g * 4) = o;
        }
    }
    __syncthreads();
    f32x4 oa[4], ob[4];
#pragma unroll
    for (int nt = 0; nt < 4; ++nt) { oa[nt] = (f32x4){0.f, 0.f, 0.f, 0.f}; ob[nt] = (f32x4){0.f, 0.f, 0.f, 0.f}; }
#pragma unroll
    for (int ks = 0; ks < 2; ++ks) {
        const bf16x8 a = *(const bf16x8*)(q16 + (16 * w + fr) * 72 + ks * 32 + g * 8);
        const bf16x8 a2 = *(const bf16x8*)(att + (16 * w + fr) * 72 + ks * 32 + g * 8);
#pragma unroll
        for (int nt = 0; nt < 4; ++nt) {
            const bf16x8 bb = *(const bf16x8*)(St + (nt * 16 + fr) * 72 + ks * 32 + g * 8); oa[nt] = mfma16(a, bb, oa[nt]);
            const bf16x8 b2 = *(const bf16x8*)(vnT + (nt * 16 + fr) * 72 + ks * 32 + g * 8); ob[nt] = mfma16(a2, b2, ob[nt]);
        }
    }
    float eg4[4], ss[4];
#pragma unroll
    for (int j = 0; j < 4; ++j) { eg4[j] = __expf(gcl[16 * w + g * 4 + j]); ss[j] = 0.f; }
    float ov[4][4];
#pragma unroll
    for (int nt = 0; nt < 4; ++nt)
#pragma unroll
        for (int j = 0; j < 4; ++j) { ov[nt][j] = oa[nt][j] * eg4[j] + ob[nt][j]; ss[j] += ov[nt][j] * ov[nt][j]; }
#pragma unroll
    for (int j = 0; j < 4; ++j) { ss[j] += __shfl_xor(ss[j], 1); ss[j] += __shfl_xor(ss[j], 2); ss[j] += __shfl_xor(ss[j], 4); ss[j] += __shfl_xor(ss[j], 8); ss[j] = rsqrtf(ss[j] * (1.f / 64.f) + 1e-6f); }
    if (!dry)
#pragma unroll
    for (int nt = 0; nt < 4; ++nt) {
        const float nw = p.dn_norm_w[layer * 64 + nt * 16 + fr];
#pragma unroll
        for (int j = 0; j < 4; ++j)
            P[(size_t)(tok0 + 16 * w + g * 4 + j) * LDP + C_DG + h * 64 + nt * 16 + fr] = f2bf(ov[nt][j] * ss[j] * nw * silu_f(gt[nt][j]));
    }
}

__global__ void __launch_bounds__(256, 2) mega_kernel(Params p) {
    extern __shared__ __attribute__((aligned(16))) unsigned char smem[];
    __shared__ int s_unit;
    cg::grid_group grid = cg::this_grid();
    unsigned* ctr = (unsigned*)(p.ws + WS_CTR);
    unsigned nbar = 0;
    __shared__ unsigned xb_st[2];
    if (threadIdx.x < 2) xb_st[threadIdx.x] = 0u;
    __syncthreads();
    const XcdBarrier xb = xcd_barrier_post((unsigned*)(p.ws + WS_XBAR), (volatile LAS unsigned*)xb_st);
    __shared__ int s_cu[2];
    unsigned* cutab = (unsigned*)(p.ws + WS_CUTAB);
    if (threadIdx.x == 0) {
        const unsigned xcc = __builtin_amdgcn_s_getreg((3 << 11) | 20) & 15u;
        const unsigned hw = __builtin_amdgcn_s_getreg((7 << 11) | (8 << 6) | 4) & 255u;
        const unsigned slot = (xcc << 8) | hw;
        const unsigned idx = __hip_atomic_fetch_add(&cutab[slot], 1u, __ATOMIC_RELAXED, __HIP_MEMORY_SCOPE_AGENT);
        if (idx == 0u) { const unsigned r = __hip_atomic_fetch_add(&cutab[8192], 1u, __ATOMIC_RELAXED, __HIP_MEMORY_SCOPE_AGENT); __hip_atomic_store(&cutab[4096 + slot], r + 1u, __ATOMIC_RELAXED, __HIP_MEMORY_SCOPE_AGENT); }
        s_cu[0] = (idx == 0u) ? 1 : 0; s_cu[1] = (int)slot;
    }
    __syncthreads();
    for (int ph = p.ph_lo; ph < p.ph_hi; ++ph) {
        if (ph == 0) {
            for (;;) { const int u = next_unit(ctr + ph, &s_unit); if (u >= 384 + 128 + 512) break; if (u < 384) conv_win_unit(p, 0, u); else if (u < 512) conv_wout_unit(p, u - 384); else conv_x_unit(p, u - 512); }
#if PROBE == 10 || PROBE == 11
            {
                const bf16_t* Pp = (const bf16_t*)(p.ws + WS_P); unsigned acc = 0; const int tid_ = threadIdx.x; const int cg_ = tid_ & 7, r0_ = tid_ >> 3;
                for (int it = 0; it < 400; ++it) {
                    const int T = (int)((blockIdx.x * 131u + (unsigned)it * 1777u) % (128u * 92u));
                    const int rb = T % 128, cb = T / 128;
#pragma unroll
                    for (int i = 0; i < 4; ++i) {
                        const int row = r0_ + 32 * i;
                        const size_t ad = (PROBE == 10) ? ((size_t)(rb * 128 + row) * LDP + cb * 64 + cg_ * 8) : ((size_t)T * 8192 + row * 64 + cg_ * 8);
                        const uint4 v = *(const uint4*)(Pp + ad); acc += v.x ^ v.y ^ v.z ^ v.w;
                    }
                    __syncthreads();
                }
                if (acc == 0x12345u) ((unsigned*)(p.ws + WS_CTR))[255] = acc;
            }
#endif
        } else {
            const int layer = (ph - 1) / 6, sub = (ph - 1) % 6;
            if (sub == 0) {
                const int xcd0 = (int)(__builtin_amdgcn_s_getreg((3 << 11) | 20) & 7u);
                for (int rep = 0; rep < ((PROBE == 1 || PROBE == 15) ? 2 : 1); ++rep)
                for (int sx = 0; sx < 8; ++sx) {
                    const int x = (xcd0 + sx) & 7;
                    unsigned* cq = ctr + 64 + rep * 64 + (layer * 2) * 8 + x;
                    int q = next_unit(cq, &s_unit);
                    while (q < 752) {
                        unsigned nxq = 0u; if (threadIdx.x == 0) nxq = __hip_atomic_fetch_add(cq, 1u, __ATOMIC_RELAXED, __HIP_MEMORY_SCOPE_AGENT);
                        const int tmg = q / 376, r = q % 376; const int tng = r >> 6, rr = r & 63;
                        gemm_unit<0>(p, layer, x * 16 + tmg * 8 + (rr & 7), tng * 8 + (rr >> 3), smem, PROBE == 15 && rep == 0);
                        __syncthreads(); if (threadIdx.x == 0) s_unit = (int)nxq; __syncthreads(); q = s_unit;
                    }
                }
            } else if (sub == 1) {
                const int n0 = 64, n1 = n0 + 256, n2 = n1 + 1536, n3 = n2 + 1536;
                for (int rep = (PROBE == 4 ? 0 : 1); rep < 2; ++rep) {
                if (rep == 1 && PROBE == 4) { ++nbar; grid_barrier(ctr + 48, nbar * gridDim.x); }
                for (;;) {
                    const bool dry = rep == 0;
                    const int u = next_unit(ctr + ph + (dry ? 16 : 0), &s_unit); if (u >= n3) break;
                    if (u < n0) kmean_unit(p, u, smem);
                    else if (u < n1) ssd_states_unit(p, layer, u - n0, smem);
                    else if (u < n2) delta_prep_unit(p, layer, u - n1, smem, dry);
                    else dil_unit(p, 0, u - n2, smem, dry);
                }
                }
            } else if (sub == 2) {
                const int xcd0 = (int)(__builtin_amdgcn_s_getreg((3 << 11) | 20) & 7u);
                const unsigned nprim = __hip_atomic_load(&cutab[8192], __ATOMIC_RELAXED, __HIP_MEMORY_SCOPE_AGENT);
                const int curank = (int)__hip_atomic_load(&cutab[4096 + s_cu[1]], __ATOMIC_RELAXED, __HIP_MEMORY_SCOPE_AGENT) - 1;
                const bool excl = nprim >= 12u;
                if (excl && curank >= 0 && curank < 12) {
                    if (s_cu[0]) delta_scan_unit(p, layer, curank, smem, false);
                } else {
                    for (;;) { const int u = next_unit(ctr + ph, &s_unit); if (u >= 60) break; if (u < 12) { if (!excl) delta_scan_unit(p, layer, u, smem, false); } else ssd_scan_unit(p, u - 12); }
                    for (int sx = 0; sx < 8; ++sx) {
                        const int x = (xcd0 + sx) & 7;
                        for (;;) { const int q = next_unit(ctr + 200 + layer * 8 + x, &s_unit); if (q >= 96) break; moba_unit(p, x, q, smem, false); }
                    }
                    for (;;) { const int u = next_unit(ctr + 240 + layer, &s_unit); if (u >= 1536) break; dil_unit(p, 1, u, smem, false); }
                }
            } else if (sub == 3) {
                unsigned* qa = ctr + 234 + layer * 2; unsigned* qb = qa + 1;
                for (int pass = 0; pass < 2; ++pass) {
                    const bool longq = (pass == 0) == (s_cu[0] != 0);
                    if (longq) { for (;;) { const int u = next_unit(qa, &s_unit); if (u >= 256) break; ssd_out_unit(p, layer, u, smem, false); } }
                    else { for (;;) { const int u = next_unit(qb, &s_unit); if (u >= 3072) break; if (u < 1536) dil_unit(p, 2, u, smem, false); else delta_out_unit(p, layer, u - 1536, smem, false); } }
                }
            } else if (sub == 4) {
                if (layer == 0) { for (;;) { const int u = next_unit(ctr + ph, &s_unit); if (u >= 384) break; conv_win_unit(p, 1, u); } }
                const int xcd0 = (int)(__builtin_amdgcn_s_getreg((3 << 11) | 20) & 7u);
                for (int sx = 0; sx < 8; ++sx) {
                    const int x = (xcd0 + sx) & 7;
                    unsigned* cq = ctr + 64 + (layer * 2 + 1) * 8 + x;
                    int q = next_unit(cq, &s_unit);
                    while (q < 128) {
                        unsigned nxq = 0u; if (threadIdx.x == 0) nxq = __hip_atomic_fetch_add(cq, 1u, __ATOMIC_RELAXED, __HIP_MEMORY_SCOPE_AGENT);
                        const int tmg = q >> 6, rr = q & 63;
                        gemm_unit<1>(p, layer, x * 16 + tmg * 8 + (rr & 7), rr >> 3, smem);
                        __syncthreads(); if (threadIdx.x == 0) s_unit = (int)nxq; __syncthreads(); q = s_unit;
                    }
                }
            } else {
                for (;;) { const int u = next_unit(ctr + ph, &s_unit); if (u >= 512) break; ln_unit(p, layer, u); }
            }
        }
        if (ph + 1 < p.ph_hi) {
            if (p.ph_lo < 0) grid.sync();
            xcd_barrier(xb);
        }
    }
}

extern "C" void kernel_launch(void* const* d_in, const int* in_sizes, int n_in, void* d_out, int out_size, void* d_ws, size_t ws_size, hipStream_t stream) {
    static int grid_blocks = 0;
    if (!grid_blocks) {
        if (n_in != 16 || ws_size < WS_END) { fprintf(stderr, "kernel_launch: bad args n_in=%d ws=%zu need %zu\n", n_in, ws_size, (size_t)WS_END); grid_blocks = -1; return; }
        int dev = 0, cus = 0, per_cu = 0;
        hipGetDevice(&dev);
        hipDeviceGetAttribute(&cus, hipDeviceAttributeMultiprocessorCount, dev);
        if (hipFuncSetAttribute((const void*)mega_kernel, hipFuncAttributeMaxDynamicSharedMemorySize, LDS_BYTES) != hipSuccess) fprintf(stderr, "hipFuncSetAttribute failed\n");
        if (hipOccupancyMaxActiveBlocksPerMultiprocessor(&per_cu, (const void*)mega_kernel, 256, LDS_BYTES) != hipSuccess || per_cu < 1) { fprintf(stderr, "occupancy query failed/0: %d\n", per_cu); per_cu = 1; }
        (void)hipGetLastError();
        if (per_cu > 2) per_cu = 2;
        grid_blocks = cus * per_cu;
        fprintf(stderr, "kernel_launch: cus=%d per_cu=%d grid=%d ws_need=%zu ws=%zu\n", cus, per_cu, grid_blocks, (size_t)WS_END, ws_size);
    }
    if (grid_blocks < 0) return;
    (void)hipMemsetAsync((char*)d_ws + WS_XBAR, 0, WS_END - WS_XBAR, stream);
    Params p{};
    p.x = (const float*)d_in[0]; p.w_in = (const float*)d_in[1]; p.w_out = (const float*)d_in[2];
    p.ssm_conv_w = (const float*)d_in[3]; p.ssm_conv_b = (const float*)d_in[4]; p.ssm_dt_bias = (const float*)d_in[5]; p.ssm_A_log = (const float*)d_in[6];
    p.ssm_D = (const float*)d_in[7]; p.ssm_norm_w = (const float*)d_in[8];
    p.dn_conv_w = (const float*)d_in[9]; p.dn_conv_b = (const float*)d_in[10]; p.dn_dt_bias = (const float*)d_in[11]; p.dn_A_log = (const float*)d_in[12]; p.dn_norm_w = (const float*)d_in[13];
    p.ln_g = (const float*)d_in[14]; p.ln_b = (const float*)d_in[15];
    p.out = (float*)d_out; p.ws = (unsigned char*)d_ws; p.ph_lo = 0; p.ph_hi = 13;
    void* args[] = {&p};
    hipError_t e = hipLaunchCooperativeKernel((const void*)mega_kernel, dim3(grid_blocks), dim3(256), args, LDS_BYTES, stream);
    if (e != hipSuccess) fprintf(stderr, "cooperative launch failed: %s (grid %d)\n", hipGetErrorString(e), grid_blocks);
}
#ifdef PROBE_UNITS
#define PK(name, call) __global__ void __launch_bounds__(256, 2) name(Params p, int u) { extern __shared__ __attribute__((aligned(16))) unsigned char smem[]; call; }
PK(k_convwin, conv_win_unit(p, 0, u))
PK(k_convwout, conv_wout_unit(p, u))
PK(k_gemm0, gemm_unit<0>(p, 0, u, u, smem))
PK(k_gemm1, gemm_unit<1>(p, 0, u, u, smem))
PK(k_ln, ln_unit(p, 0, u))
PK(k_kmean, kmean_unit(p, u, smem))
PK(k_moba, moba_unit(p, u & 7, u, smem))
PK(k_dil, dil_unit(p, p.ph_lo, u, smem))
PK(k_ssdst, ssd_states_unit(p, 0, u, smem))
PK(k_ssdscan, ssd_scan_unit(p, u))
PK(k_ssdout, ssd_out_unit(p, 0, u, smem))
PK(k_dprep, delta_prep_unit(p, 0, u, smem))
PK(k_dscan, delta_scan_unit(p, 0, u, smem))
PK(k_dout, delta_out_unit(p, 0, u, smem))
#endif
```
